# Optimizing an MI355X kernel written in HIP

```python
import jax, jax.numpy as jnp
from jax import lax
import numpy as np

D_MODEL = 1024
BATCH = 8
SEQ = 4096
DEPTH = 4

N_HEADS = 16
HEAD_DIM = D_MODEL // N_HEADS
N_KV_HEADS = 4
GROUP = N_HEADS // N_KV_HEADS
ROT_DIM = HEAD_DIM // 4
ROPE_THETA = 500000.0
WINDOW = 128
BLOCK = 128
CONV_WIDTH = D_MODEL
CONV_K = 3
D_FF = -(-8 * D_MODEL // (3 * 256)) * 256
Q_W = N_HEADS * HEAD_DIM
KV_W = N_KV_HEADS * HEAD_DIM
IN_COLS = Q_W + 2 * KV_W + 3 * CONV_WIDTH + 2 * D_MODEL
RMS_EPS = 1e-6
NEG_INF = -1e30

kernel_name = "hybrid_gated_swa_shortconv_encoder"


def rms_norm(x, g):
    xf = x.astype(jnp.float32)
    y = xf * lax.rsqrt(jnp.mean(xf * xf, axis=-1, keepdims=True) + RMS_EPS)
    return (y * g.astype(jnp.float32)).astype(x.dtype)


def rope_tables(seq):
    pos = jnp.arange(seq, dtype=jnp.float32)
    inv = jnp.power(ROPE_THETA, -jnp.arange(0, ROT_DIM, 2, dtype=jnp.float32) / ROT_DIM)
    ang = pos[:, None] * inv[None, :]
    return jnp.cos(ang), jnp.sin(ang)


def partial_rope(t, cos, sin):
    tf = t.astype(jnp.float32)
    half = ROT_DIM // 2
    x1, x2, rest = tf[..., :half], tf[..., half:ROT_DIM], tf[..., ROT_DIM:]
    c, s = cos[None, :, None, :], sin[None, :, None, :]
    out = jnp.concatenate([x1 * c - x2 * s, x2 * c + x1 * s, rest], axis=-1)
    return out.astype(t.dtype)


def band_attention(q, k, v, sink):
    b, s = q.shape[0], q.shape[1]
    nb = s // BLOCK
    qb = q.reshape(b, nb, BLOCK, N_KV_HEADS, GROUP, HEAD_DIM).transpose(1, 0, 2, 3, 4, 5)

    def windows(t):
        tp = jnp.pad(t, ((0, 0), (BLOCK, BLOCK), (0, 0), (0, 0)))
        tb = tp.reshape(b, nb + 2, BLOCK, N_KV_HEADS, HEAD_DIM)
        w = jnp.concatenate([tb[:, :-2], tb[:, 1:-1], tb[:, 2:]], axis=2)
        return w.transpose(1, 0, 2, 3, 4)

    kw, vw = windows(k), windows(v)
    blk = jnp.arange(nb)
    q_idx = blk[:, None] * BLOCK + jnp.arange(BLOCK)[None, :]
    k_idx = (blk[:, None] - 1) * BLOCK + jnp.arange(3 * BLOCK)[None, :]
    mask = ((jnp.abs(q_idx[:, :, None] - k_idx[:, None, :]) <= WINDOW)
            & (k_idx[:, None, :] >= 0) & (k_idx[:, None, :] < s))
    sink_f = sink.astype(jnp.float32).reshape(N_KV_HEADS, GROUP)[None, :, :, None, None]
    scale = HEAD_DIM ** -0.5

    def one_block(args):
        qi, ki, vi, mi = args
        sc = jnp.einsum('bqkgd,bskd->bkgqs', qi.astype(jnp.float32), ki.astype(jnp.float32)) * scale
        sc = jnp.where(mi[None, None, None], sc, NEG_INF)
        m = jnp.maximum(jnp.max(sc, axis=-1, keepdims=True), sink_f)
        p = jnp.exp(sc - m)
        denom = jnp.sum(p, axis=-1, keepdims=True) + jnp.exp(sink_f - m)
        o = jnp.einsum('bkgqs,bskd->bqkgd', p / denom, vi.astype(jnp.float32))
        return o.astype(qi.dtype)

    o = lax.map(one_block, (qb, kw, vw, mask))
    return o.transpose(1, 0, 2, 3, 4, 5).reshape(b, s, Q_W)


def short_conv(u, w):
    up = jnp.pad(u, ((0, 0), (1, 1), (0, 0)))
    return up[:, :-2] * w[0] + up[:, 1:-1] * w[1] + up[:, 2:] * w[2]


def setup_inputs(seed: int = 0) -> dict:
    key = jax.random.key(seed)
    ks = jax.random.split(key, 16)
    f32 = jnp.float32

    def nrm(k, shape, fan_in):
        return jax.random.normal(k, shape, f32) * (fan_in ** -0.5)

    def gain(k):
        return 1.0 + 0.05 * jax.random.normal(k, (DEPTH, D_MODEL), f32)

    return {
        "x": jax.random.normal(ks[0], (BATCH, SEQ, D_MODEL), f32),
        "g_pre_mix": gain(ks[1]),
        "w_in": nrm(ks[2], (DEPTH, D_MODEL, IN_COLS), D_MODEL),
        "attn_sink": 0.5 * jax.random.normal(ks[3], (DEPTH, N_HEADS), f32),
        "conv_w": nrm(ks[4], (DEPTH, CONV_K, CONV_WIDTH), CONV_K),
        "w_attn_proj": nrm(ks[5], (DEPTH, Q_W, D_MODEL), Q_W),
        "w_conv_proj": nrm(ks[6], (DEPTH, CONV_WIDTH, D_MODEL), CONV_WIDTH),
        "w_out": nrm(ks[7], (DEPTH, D_MODEL, D_MODEL), D_MODEL),
        "g_post_mix": gain(ks[8]),
        "g_pre_ffn": gain(ks[9]),
        "w_gate": nrm(ks[10], (DEPTH, D_MODEL, D_FF), D_MODEL),
        "w_up": nrm(ks[11], (DEPTH, D_MODEL, D_FF), D_MODEL),
        "w_down": nrm(ks[12], (DEPTH, D_FF, D_MODEL), D_FF),
        "g_post_ffn": gain(ks[13]),
    }


def reference(x, g_pre_mix, w_in, attn_sink, conv_w, w_attn_proj, w_conv_proj, w_out,
              g_post_mix, g_pre_ffn, w_gate, w_up, w_down, g_post_ffn):
    b, s, _ = x.shape
    cos, sin = rope_tables(s)
    splits = np.cumsum([Q_W, KV_W, KV_W, CONV_WIDTH, CONV_WIDTH, CONV_WIDTH, D_MODEL]).tolist()
    for l in range(DEPTH):
        h = rms_norm(x, g_pre_mix[l])
        z = h @ w_in[l]
        q, k, v, cb, cc, cx, ga, gb = jnp.split(z, splits, axis=-1)
        q = partial_rope(q.reshape(b, s, N_HEADS, HEAD_DIM), cos, sin)
        k = partial_rope(k.reshape(b, s, N_KV_HEADS, HEAD_DIM), cos, sin)
        v = v.reshape(b, s, N_KV_HEADS, HEAD_DIM)
        y_attn = band_attention(q, k, v, attn_sink[l]) @ w_attn_proj[l]
        y_conv = (cb * short_conv(cc * cx, conv_w[l])) @ w_conv_proj[l]
        mix = (jax.nn.sigmoid(ga) * y_attn + jax.nn.sigmoid(gb) * y_conv) @ w_out[l]
        x = x + rms_norm(mix, g_post_mix[l])
        h = rms_norm(x, g_pre_ffn[l])
        f = (jax.nn.silu(h @ w_gate[l]) * (h @ w_up[l])) @ w_down[l]
        x = x + rms_norm(f, g_post_ffn[l])
    return x
```

```cpp
#include <hip/hip_runtime.h>
#include <hip/hip_cooperative_groups.h>
#include <cstdio>
#include <cstdint>
namespace cg = cooperative_groups;

#ifndef MK_MULTI
#define MK_MULTI 0
#endif

#define LAS __attribute__((address_space(3)))
typedef unsigned short bf16_t;
typedef short bf16x8 __attribute__((ext_vector_type(8)));
typedef float f32x4 __attribute__((ext_vector_type(4)));
typedef float f32x16 __attribute__((ext_vector_type(16)));
typedef unsigned u32x4 __attribute__((ext_vector_type(4)));
typedef unsigned u32x2 __attribute__((ext_vector_type(2)));

constexpr int BATCH = 8, SEQ = 4096, DM = 1024, DEPTH = 4, NH = 16, HD = 64, NKV = 4, DFF = 2816;
constexpr int T = BATCH * SEQ;
constexpr int INC = 6656;
constexpr int NGU = 2 * DFF;
constexpr float RMS_EPS = 1e-6f;
constexpr float LOG2E = 1.4426950408889634f;
constexpr float QSCALE = 0.125f * LOG2E;
constexpr int NWAVES = 8, NTHREADS = 512;
constexpr int LDS_BYTES = 131072;
constexpr int NPHASES = 1 + 8 * DEPTH;

constexpr size_t MiB = 1u << 20;
constexpr size_t WS_ROPE = 0;
constexpr size_t WS_W0 = 1 * MiB, WS_WSTRIDE = 36 * MiB;
constexpr size_t WS_H = 73 * MiB;
constexpr size_t WS_Z = 137 * MiB;
constexpr size_t ZQ = 0, ZK = 64 * MiB, ZV = 80 * MiB, ZCB = 96 * MiB, ZU = 160 * MiB, ZSGA = 224 * MiB, ZSGB = 288 * MiB;
constexpr size_t ZY = 0, ZACT = 128 * MiB;
constexpr size_t WS_END = WS_Z + 352 * MiB;
constexpr size_t WO_IN = 0, WO_A = (size_t)INC * DM, WO_C = WO_A + (size_t)DM * DM, WO_O = WO_C + (size_t)DM * DM,
                 WO_GU = WO_O + (size_t)DM * DM, WO_D = WO_GU + (size_t)NGU * DM, WO_END = WO_D + (size_t)DM * DFF;
static_assert(WO_END * 2 <= WS_WSTRIDE, "weight buffer");
static_assert(ZACT + (size_t)T * DFF * 2 <= 352 * MiB, "act overlay");

typedef float f32x2_t __attribute__((ext_vector_type(2))); typedef __bf16 bf16x2_t __attribute__((ext_vector_type(2)));
__device__ __forceinline__ unsigned cvt_pk_bf16(float lo, float hi) { const f32x2_t v = {lo, hi}; const bf16x2_t b = __builtin_convertvector(v, bf16x2_t); return __builtin_bit_cast(unsigned, b); }
__device__ __forceinline__ float bf_lo(unsigned u) { return __uint_as_float(u << 16); }
__device__ __forceinline__ float bf_hi(unsigned u) { return __uint_as_float(u & 0xffff0000u); }
__device__ __forceinline__ float fast_sigmoid(float g) { return __builtin_amdgcn_rcpf(1.0f + __builtin_amdgcn_exp2f(-g * LOG2E)); }
__device__ __forceinline__ float wave_sum(float v) {
#pragma unroll
    for (int o = 1; o < 64; o <<= 1) v += __shfl_xor(v, o);
    return v;
}

namespace pg8 {
constexpr int BM = 256, BK = 64, HALF = 128, HTB = HALF * BK * 2, STAGE_BYTES = 8 * HTB, NXCD = 8, WGM = 8;
__host__ __device__ __forceinline__ int lds_byte(int r, int c) { const int st = (r >> 4) * 2 + (c >> 5), rr = r & 15, cc = c & 31, ob = rr * 64 + cc * 2; return st * 1024 + (ob ^ (((ob >> 9) & 1) << 5)); }
__host__ __device__ __forceinline__ void stage_rc(int b, int& R, int& C) { const int st = b / 1024, sb = b % 1024, swz = sb ^ (((sb >> 9) & 1) << 5); R = (st >> 1) * 16 + swz / 64; C = (st & 1) * 32 + (swz % 64) / 2; }
__host__ __device__ __forceinline__ int perm32(int rho) { const int n = rho >> 4, i = rho & 15; return 8 * (i >> 2) + 4 * n + (i & 3); }

struct Unit { int pm, pn, kind; };
struct Order {
    int nM, nN, nwg, G, c;
    __device__ void init(int M, int N, int G_, int c_) { nM = M / BM; nN = N / BM; nwg = nM * nN; G = G_; c = c_; }
    __device__ bool tile(long L, int& pm, int& pn) const {
        if (L >= nwg) return false;
        int wgid = (int)L; { const int q = nwg / NXCD, r = nwg % NXCD, xcd = wgid % NXCD, off = wgid / NXCD; wgid = (xcd < r ? xcd * (q + 1) : r * (q + 1) + (xcd - r) * q) + off; }
        const int nig = WGM * nN, gid = wgid / nig, fm = gid * WGM, gsz = (nM - fm) < WGM ? (nM - fm) : WGM;
        pm = fm + ((wgid % nig) % gsz); pn = (wgid % nig) / gsz; return true;
    }
};
struct SchedG {
    Order o; const char* A; const char* Bt; size_t ta, tb;
    __device__ __forceinline__ bool next(int i, Unit& u) const { u.kind = 0; return o.tile((long)i * o.G + o.c, u.pm, u.pn); }
    __device__ __forceinline__ const char* aptr(const Unit& u) const { return A + (size_t)u.pm * ta; }
    __device__ __forceinline__ const char* bptr(const Unit& u) const { return Bt + (size_t)u.pn * tb; }
    __device__ __forceinline__ bool keep(const Unit&) const { return false; }
};
struct SchedPair {
    Order o; const char* A0; const char* A1; const char* B0; const char* B1; size_t ta, tb;
    __device__ __forceinline__ bool next(int i, Unit& u) const { u.kind = i & 1; return o.tile((long)(i >> 1) * o.G + o.c, u.pm, u.pn); }
    __device__ __forceinline__ const char* aptr(const Unit& u) const { return (u.kind ? A1 : A0) + (size_t)u.pm * ta; }
    __device__ __forceinline__ const char* bptr(const Unit& u) const { return (u.kind ? B1 : B0) + (size_t)u.pn * tb; }
    __device__ __forceinline__ bool keep(const Unit& u) const { return u.kind == 0; }
};

template <class Epi, class Sched, bool ALIGN_EPI, bool SP2>
__device__ __forceinline__ void gemm_phase(LAS unsigned char* lds, const int tid, const int K, const Sched& S, const Epi& E) {
    const int wid = __builtin_amdgcn_readfirstlane(tid >> 6), lane = tid & 63, wr = wid >> 2, wc = wid & 3, fr = lane & 15, fq = lane >> 4;
    const int nt = K / BK;
    unsigned voffA[2], voffB[2];
#pragma unroll
    for (int i = 0; i < 2; ++i) { int R, C; stage_rc(tid * 16 + i * 8192, R, C); const int Rb = Epi::PERM ? ((R & ~31) + perm32(R & 31)) : R;
        voffA[i] = (unsigned)(R * K + C) * 2u; voffB[i] = (unsigned)(Rb * K + C) * 2u; }
    const size_t kstep = (size_t)(BK * 2);
    const size_t hstep = (size_t)HALF * K * 2;
    const unsigned ldsw = (unsigned)wid * 1024u;
    const int aoff = lds_byte(wr * 64 + fr, fq * 8), boff = lds_byte(wc * 32 + fr, fq * 8);
#define PG8_SA(b, h) (((b) * 2 + (h)) * HTB)
#define PG8_SB(b, h) ((4 + (b) * 2 + (h)) * HTB)
#define PG8_STAGE(bufoff, gbase, voff) do { _Pragma("unroll") for (int _i = 0; _i < 2; ++_i) \
        __builtin_amdgcn_global_load_lds((const unsigned*)((const char*)(gbase) + (voff)[_i]), (LAS unsigned*)(lds + (bufoff) + ldsw + _i * 8192), 16, 0, 0); } while (0)
#define PG8_LDA(dst, b, h) do { _Pragma("unroll") for (int m = 0; m < 4; ++m) _Pragma("unroll") for (int k = 0; k < 2; ++k) dst[m][k] = *(const LAS bf16x8*)(lds + PG8_SA(b, h) + aoff + m * 2048 + k * 1024); } while (0)
#define PG8_LDB(dst, b, h) do { _Pragma("unroll") for (int n = 0; n < 2; ++n) _Pragma("unroll") for (int k = 0; k < 2; ++k) dst[n][k] = *(const LAS bf16x8*)(lds + PG8_SB(b, h) + boff + n * 2048 + k * 1024); } while (0)
#define PG8_MMA(ai, bj, At, Bt) do { __builtin_amdgcn_s_setprio(1); _Pragma("unroll") for (int m = 0; m < 4; ++m) _Pragma("unroll") for (int n = 0; n < 2; ++n) _Pragma("unroll") for (int k = 0; k < 2; ++k) \
        acc[ai][bj][m][n] = __builtin_amdgcn_mfma_f32_16x16x32_bf16(Bt[n][k], At[m][k], acc[ai][bj][m][n], 0, 0, 0); __builtin_amdgcn_s_setprio(0); } while (0)
#define PG8_WAIT_V(n) asm volatile("s_waitcnt vmcnt(" #n ")" ::: "memory")
#define PG8_WAIT_L(n) asm volatile("s_waitcnt lgkmcnt(" #n ")" ::: "memory")
#define PG8_BAR __builtin_amdgcn_s_barrier()
#define PG8_SCHED __builtin_amdgcn_sched_barrier(0)
    Unit cur, nxt; int ui = 0;
    if (!S.next(0, cur)) return;
    f32x4 acc[2][2][4][2];
#pragma unroll
    for (int a = 0; a < 2; ++a)
#pragma unroll
        for (int b = 0; b < 2; ++b)
#pragma unroll
            for (int m = 0; m < 4; ++m)
#pragma unroll
                for (int n = 0; n < 2; ++n) acc[a][b][m][n] = (f32x4){0.f, 0.f, 0.f, 0.f};
    bf16x8 At[4][2], B0[2][2], B1[2][2];
    const char* cA = S.aptr(cur); const char* cB = S.bptr(cur);
    if constexpr (SP2) {
        PG8_STAGE(PG8_SB(0, 0), cB, voffB); PG8_STAGE(PG8_SB(0, 1), cB + hstep, voffB); PG8_STAGE(PG8_SA(0, 0), cA, voffA); PG8_STAGE(PG8_SA(0, 1), cA + hstep, voffA);
        if (wr == 1) PG8_BAR;
        PG8_WAIT_V(2); PG8_BAR;
        PG8_STAGE(PG8_SB(1, 0), cB + kstep, voffB); PG8_STAGE(PG8_SA(1, 0), cA + kstep, voffA); PG8_STAGE(PG8_SB(1, 1), cB + hstep + kstep, voffB);
        PG8_WAIT_V(6); PG8_BAR;
    } else {
        PG8_STAGE(PG8_SB(0, 0), cB, voffB); PG8_STAGE(PG8_SA(0, 0), cA, voffA); PG8_STAGE(PG8_SB(0, 1), cB + hstep, voffB); PG8_STAGE(PG8_SA(0, 1), cA + hstep, voffA);
        if (wr == 1) PG8_BAR;
        PG8_WAIT_V(4); PG8_BAR;
        PG8_STAGE(PG8_SB(1, 0), cB + kstep, voffB); PG8_STAGE(PG8_SA(1, 0), cA + kstep, voffA); PG8_STAGE(PG8_SB(1, 1), cB + hstep + kstep, voffB);
        PG8_WAIT_V(6); PG8_BAR;
    }
    for (;;) {
        const bool has_next = S.next(ui + 1, nxt);
        const char* nA = has_next ? S.aptr(nxt) : cA; const char* nB = has_next ? S.bptr(nxt) : cB;
        for (int t = 0; t < nt; t += 2) {
            const bool last = (t == nt - 2);
            const char* a1 = cA + (size_t)(t + 1) * kstep;
            const char* a2 = last ? nA : cA + (size_t)(t + 2) * kstep; const char* b2 = last ? nB : cB + (size_t)(t + 2) * kstep;
            const char* a3 = a2 + kstep; const char* b3 = b2 + kstep;
            if constexpr (SP2) {
            PG8_LDB(B0, 0, 0); PG8_LDB(B1, 0, 1); PG8_SCHED; PG8_LDA(At, 0, 0); PG8_STAGE(PG8_SA(1, 1), a1 + hstep, voffA);
            PG8_WAIT_V(8); PG8_WAIT_L(0); PG8_BAR; PG8_MMA(0, 0, At, B0); PG8_MMA(0, 1, At, B1); PG8_BAR; PG8_SCHED;
            PG8_LDA(At, 0, 1); PG8_STAGE(PG8_SB(0, 0), b2, voffB); PG8_STAGE(PG8_SB(0, 1), b2 + hstep, voffB); PG8_STAGE(PG8_SA(0, 0), a2, voffA);
            PG8_WAIT_V(8); PG8_WAIT_L(0); PG8_BAR; PG8_MMA(1, 0, At, B0); PG8_MMA(1, 1, At, B1); PG8_BAR; PG8_SCHED;
            PG8_LDB(B0, 1, 0); PG8_LDB(B1, 1, 1); PG8_SCHED; PG8_LDA(At, 1, 0); PG8_STAGE(PG8_SA(0, 1), a2 + hstep, voffA);
            PG8_WAIT_V(8); PG8_WAIT_L(0); PG8_BAR; PG8_MMA(0, 0, At, B0); PG8_MMA(0, 1, At, B1); PG8_BAR; PG8_SCHED;
            PG8_LDA(At, 1, 1); PG8_STAGE(PG8_SB(1, 0), b3, voffB); PG8_STAGE(PG8_SB(1, 1), b3 + hstep, voffB); PG8_STAGE(PG8_SA(1, 0), a3, voffA);
            PG8_WAIT_V(8); PG8_WAIT_L(0); PG8_BAR; PG8_MMA(1, 0, At, B0); PG8_MMA(1, 1, At, B1); PG8_BAR; PG8_SCHED;
            } else {
            PG8_LDB(B0, 0, 0); PG8_SCHED; PG8_LDA(At, 0, 0); PG8_STAGE(PG8_SA(1, 1), a1 + hstep, voffA);
            PG8_WAIT_L(8); PG8_BAR; PG8_WAIT_L(0); PG8_MMA(0, 0, At, B0); PG8_BAR; PG8_SCHED;
            PG8_LDB(B1, 0, 1); PG8_STAGE(PG8_SB(0, 0), b2, voffB);
            PG8_BAR; PG8_WAIT_L(0); PG8_MMA(0, 1, At, B1); PG8_BAR;
            PG8_LDA(At, 0, 1); PG8_STAGE(PG8_SA(0, 0), a2, voffA);
            PG8_BAR; PG8_WAIT_L(0); PG8_MMA(1, 0, At, B0); PG8_BAR; PG8_SCHED;
            PG8_STAGE(PG8_SB(0, 1), b2 + hstep, voffB);
            PG8_WAIT_V(6); PG8_BAR; PG8_MMA(1, 1, At, B1); PG8_BAR;
            PG8_LDB(B0, 1, 0); PG8_SCHED; PG8_LDA(At, 1, 0); PG8_STAGE(PG8_SA(0, 1), a2 + hstep, voffA);
            PG8_WAIT_L(8); PG8_BAR; PG8_WAIT_L(0); PG8_MMA(0, 0, At, B0); PG8_BAR; PG8_SCHED;
            PG8_LDB(B1, 1, 1); PG8_STAGE(PG8_SB(1, 0), b3, voffB);
            PG8_BAR; PG8_WAIT_L(0); PG8_MMA(0, 1, At, B1); PG8_BAR;
            PG8_LDA(At, 1, 1); PG8_STAGE(PG8_SA(1, 0), a3, voffA);
            PG8_BAR; PG8_WAIT_L(0); PG8_MMA(1, 0, At, B0); PG8_BAR; PG8_SCHED;
            PG8_STAGE(PG8_SB(1, 1), b3 + hstep, voffB);
            PG8_WAIT_V(6); PG8_BAR; PG8_MMA(1, 1, At, B1); PG8_BAR;
            }
        }
        if constexpr (ALIGN_EPI) { if (wr == 0) PG8_BAR; }
        E(acc, cur, wr, wc, fr, fq);
        if (!has_next) break;
        if (!S.keep(cur)) {
#pragma unroll
            for (int a = 0; a < 2; ++a)
#pragma unroll
                for (int b = 0; b < 2; ++b)
#pragma unroll
                    for (int m = 0; m < 4; ++m)
#pragma unroll
                        for (int n = 0; n < 2; ++n) acc[a][b][m][n] = (f32x4){0.f, 0.f, 0.f, 0.f};
        }
        cur = nxt; cA = nA; cB = nB; ++ui;
        if constexpr (ALIGN_EPI) { if (wr == 1) PG8_BAR; }
    }
    PG8_WAIT_V(0);
    if constexpr (!ALIGN_EPI) { if (wr == 0) PG8_BAR; }
    PG8_BAR;
#undef PG8_SA
#undef PG8_SB
#undef PG8_STAGE
#undef PG8_LDA
#undef PG8_LDB
#undef PG8_MMA
#undef PG8_WAIT_V
#undef PG8_WAIT_L
#undef PG8_BAR
#undef PG8_SCHED
}
}

typedef f32x4 Acc[2][2][4][2];
__device__ __forceinline__ void store8(bf16_t* p, const f32x4& v0, const f32x4& v1) {
    u32x4 w; w.x = cvt_pk_bf16(v0[0], v0[1]); w.y = cvt_pk_bf16(v0[2], v0[3]); w.z = cvt_pk_bf16(v1[0], v1[1]); w.w = cvt_pk_bf16(v1[2], v1[3]);
    *(u32x4*)p = w;
}
struct EpiIn {
    static constexpr bool PERM = true;
    bf16_t *Q, *Kb, *V, *CB, *U, *SGA, *SGB; const float* rope;
    __device__ __forceinline__ void operator()(Acc& acc, const pg8::Unit& u, int wr, int wc, int fr, int fq) const {
        const int row0 = u.pm * 256 + wr * 64 + fr, pn = u.pn, cl = wc * 32 + 8 * fq;
        if (pn <= 4) {
            const bool isq = pn < 4;
            bf16_t* base = isq ? Q + pn * 256 : Kb; const int ldc = isq ? 1024 : 256; const float sc = isq ? QSCALE : 1.0f;
            const bool wrope = ((wc & 1) == 0); const bool lrope = wrope && (fq < 2);
#pragma unroll
            for (int ai = 0; ai < 2; ++ai)
#pragma unroll
                for (int m = 0; m < 4; ++m) {
                    const int row = row0 + ai * 128 + m * 16;
                    f32x4 c4 = (f32x4){1.f, 1.f, 1.f, 1.f}, s4 = (f32x4){0.f, 0.f, 0.f, 0.f};
                    if (wrope) { const float* rp = rope + (size_t)(row & (SEQ - 1)) * 16 + 4 * (fq & 1); c4 = *(const f32x4*)rp; s4 = *(const f32x4*)(rp + 8); }
#pragma unroll
                    for (int bj = 0; bj < 2; ++bj) {
                        f32x4 v0 = acc[ai][bj][m][0], v1 = acc[ai][bj][m][1];
                        const f32x4 n0 = v0 * c4 - v1 * s4, n1 = v1 * c4 + v0 * s4;
                        if (lrope) { v0 = n0; v1 = n1; }
                        v0 *= sc; v1 *= sc;
                        store8(base + (size_t)row * ldc + bj * 128 + cl, v0, v1);
                    }
                }
        } else if (pn < 10) {
            bf16_t* base = (pn == 5) ? V : CB + (pn - 6) * 256; const int ldc = (pn == 5) ? 256 : 1024;
#pragma unroll
            for (int ai = 0; ai < 2; ++ai)
#pragma unroll
                for (int m = 0; m < 4; ++m) {
                    const int row = row0 + ai * 128 + m * 16;
#pragma unroll
                    for (int bj = 0; bj < 2; ++bj) store8(base + (size_t)row * ldc + bj * 128 + cl, acc[ai][bj][m][0], acc[ai][bj][m][1]);
                }
        } else if (pn < 18) {
            bf16_t* base = U + (pn - 10) * 128;
#pragma unroll
            for (int ai = 0; ai < 2; ++ai)
#pragma unroll
                for (int m = 0; m < 4; ++m) {
                    const int row = row0 + ai * 128 + m * 16;
                    store8(base + (size_t)row * 1024 + cl, acc[ai][0][m][0] * acc[ai][1][m][0], acc[ai][0][m][1] * acc[ai][1][m][1]);
                }
        } else {
            bf16_t* base = (pn < 22) ? SGA + (pn - 18) * 256 : SGB + (pn - 22) * 256;
#pragma unroll
            for (int ai = 0; ai < 2; ++ai)
#pragma unroll
                for (int m = 0; m < 4; ++m) {
                    const int row = row0 + ai * 128 + m * 16;
#pragma unroll
                    for (int bj = 0; bj < 2; ++bj) {
                        f32x4 v0 = acc[ai][bj][m][0], v1 = acc[ai][bj][m][1];
#pragma unroll
                        for (int j = 0; j < 4; ++j) { v0[j] = fast_sigmoid(v0[j]); v1[j] = fast_sigmoid(v1[j]); }
                        store8(base + (size_t)row * 1024 + bj * 128 + cl, v0, v1);
                    }
                }
        }
    }
};
struct EpiMix {
    static constexpr bool PERM = true;
    const bf16_t *SGA, *SGB; bf16_t* MIX;
    __device__ __forceinline__ void operator()(Acc& acc, const pg8::Unit& u, int wr, int wc, int fr, int fq) const {
        const int row0 = u.pm * 256 + wr * 64 + fr, col0 = u.pn * 256 + wc * 32 + 8 * fq;
#pragma unroll
        for (int ai = 0; ai < 2; ++ai)
#pragma unroll
            for (int m = 0; m < 4; ++m) {
                const int row = row0 + ai * 128 + m * 16;
#pragma unroll
                for (int bj = 0; bj < 2; ++bj) {
                    const size_t off = (size_t)row * 1024 + col0 + bj * 128;
                    const u32x4 sbw = *(const u32x4*)(SGB + off);
                    f32x4 b0, b1;
                    b0[0] = bf_lo(sbw.x); b0[1] = bf_hi(sbw.x); b0[2] = bf_lo(sbw.y); b0[3] = bf_hi(sbw.y);
                    b1[0] = bf_lo(sbw.z); b1[1] = bf_hi(sbw.z); b1[2] = bf_lo(sbw.w); b1[3] = bf_hi(sbw.w);
#pragma unroll
                    for (int j = 0; j < 4; ++j) { b0[j] = fmaxf(b0[j], 1e-30f); b1[j] = fmaxf(b1[j], 1e-30f); }
                    if (u.kind == 0) {
                        const u32x4 saw = *(const u32x4*)(SGA + off);
                        f32x4 a0, a1;
                        a0[0] = bf_lo(saw.x); a0[1] = bf_hi(saw.x); a0[2] = bf_lo(saw.y); a0[3] = bf_hi(saw.y);
                        a1[0] = bf_lo(saw.z); a1[1] = bf_hi(saw.z); a1[2] = bf_lo(saw.w); a1[3] = bf_hi(saw.w);
#pragma unroll
                        for (int j = 0; j < 4; ++j) { acc[ai][bj][m][0][j] *= a0[j] * __builtin_amdgcn_rcpf(b0[j]); acc[ai][bj][m][1][j] *= a1[j] * __builtin_amdgcn_rcpf(b1[j]); }
                    } else {
                        store8(MIX + off, acc[ai][bj][m][0] * b0, acc[ai][bj][m][1] * b1);
                    }
                }
            }
    }
};
struct EpiF32 {
    static constexpr bool PERM = false;
    float* Y;
    __device__ __forceinline__ void operator()(Acc& acc, const pg8::Unit& u, int wr, int wc, int fr, int fq) const {
        const int row0 = u.pm * 256 + wr * 64 + fr, col0 = u.pn * 256 + wc * 32 + 4 * fq;
#pragma unroll
        for (int ai = 0; ai < 2; ++ai)
#pragma unroll
            for (int m = 0; m < 4; ++m) { float* rowp = Y + (size_t)(row0 + ai * 128 + m * 16) * 1024 + col0;
#pragma unroll
                for (int bj = 0; bj < 2; ++bj)
#pragma unroll
                    for (int n = 0; n < 2; ++n) *(f32x4*)(rowp + bj * 128 + n * 16) = acc[ai][bj][m][n]; }
    }
};
struct EpiAct {
    static constexpr bool PERM = true;
    bf16_t* ACT;
    __device__ __forceinline__ void operator()(Acc& acc, const pg8::Unit& u, int wr, int wc, int fr, int fq) const {
        const int row0 = u.pm * 256 + wr * 64 + fr, col0 = u.pn * 128 + wc * 32 + 8 * fq;
#pragma unroll
        for (int ai = 0; ai < 2; ++ai)
#pragma unroll
            for (int m = 0; m < 4; ++m) {
                f32x4 v0, v1;
#pragma unroll
                for (int j = 0; j < 4; ++j) { const float g0 = acc[ai][0][m][0][j], g1 = acc[ai][0][m][1][j];
                    v0[j] = g0 * fast_sigmoid(g0) * acc[ai][1][m][0][j]; v1[j] = g1 * fast_sigmoid(g1) * acc[ai][1][m][1][j]; }
                store8(ACT + (size_t)(row0 + ai * 128 + m * 16) * DFF + col0, v0, v1);
            }
    }
};

__device__ __forceinline__ int qperm(int p) { return (p & 3) | ((p & 4) << 1) | ((p & 8) >> 1); }
__device__ __forceinline__ int win_src_col(int n) {
    if (n < 1280) { const int p = n & 63; return (n & ~63) + (p < 16 ? qperm(p) : p); }
    if (n < 2560) return n;
    if (n < 4608) { const int t = n - 2560, j = t >> 8, c = t & 255; return (c < 128) ? 2560 + 128 * j + c : 3584 + 128 * j + (c - 128); }
    return n;
}
__device__ __forceinline__ void transpose_item(const float* W, int K, int N, int srcc, bf16_t* WT, int n0, int k0, LAS float* scr, int lane) {
#pragma unroll 8
    for (int i = 0; i < 32; ++i) { const int kk = 2 * i + (lane >> 5); scr[kk * 33 + (lane & 31)] = W[(size_t)(k0 + kk) * N + srcc]; }
    asm volatile("s_waitcnt lgkmcnt(0)" ::: "memory");
    const int c = lane & 7;
#pragma unroll
    for (int j = 0; j < 4; ++j) { const int n = (lane >> 3) + 8 * j; const LAS float* s = scr + (8 * c) * 33 + n;
        u32x4 o; o.x = cvt_pk_bf16(s[0 * 33], s[1 * 33]); o.y = cvt_pk_bf16(s[2 * 33], s[3 * 33]); o.z = cvt_pk_bf16(s[4 * 33], s[5 * 33]); o.w = cvt_pk_bf16(s[6 * 33], s[7 * 33]);
        *(u32x4*)(WT + (size_t)(n0 + n) * K + k0 + 8 * c) = o; }
    asm volatile("s_waitcnt lgkmcnt(0)" ::: "memory");
}
__device__ __forceinline__ void convert_layer(const float* w_in, const float* w_attn, const float* w_conv, const float* w_out, const float* w_gate, const float* w_up, const float* w_down, bf16_t* wb, LAS unsigned char* lds, int gw, int ngw, int wave, int lane) {
    LAS float* scr = (LAS float*)(lds + wave * 8448);
    constexpr int I_IN = (DM / 64) * (INC / 32), I_SQ = (DM / 64) * (DM / 32), I_GU = (DM / 64) * (NGU / 32), I_D = (DFF / 64) * (DM / 32);
    constexpr int NITEMS = I_IN + 3 * I_SQ + I_GU + I_D;
    for (int it = gw; it < NITEMS; it += ngw) {
        int r = it;
        if (r < I_IN) { const int nb = r % (INC / 32), kb = r / (INC / 32); transpose_item(w_in, DM, INC, win_src_col(nb * 32 + (lane & 31)), wb + WO_IN, nb * 32, kb * 64, scr, lane); continue; } r -= I_IN;
        if (r < 3 * I_SQ) { const int which = r / I_SQ; r -= which * I_SQ; const int nb = r % (DM / 32), kb = r / (DM / 32);
            const float* src = which == 0 ? w_attn : (which == 1 ? w_conv : w_out);
            transpose_item(src, DM, DM, nb * 32 + (lane & 31), wb + WO_A + (size_t)which * DM * DM, nb * 32, kb * 64, scr, lane); continue; } r -= 3 * I_SQ;
        if (r < I_GU) { const int nb = r % (NGU / 32), kb = r / (NGU / 32); const int n0 = nb * 32, j = n0 >> 8, c = n0 & 255;
            const float* src = (c < 128) ? w_gate : w_up;
            transpose_item(src, DM, DFF, 128 * j + (c & 127) + (lane & 31), wb + WO_GU, n0, kb * 64, scr, lane); continue; } r -= I_GU;
        { const int nb = r % (DM / 32), kb = r / (DM / 32); transpose_item(w_down, DFF, DM, nb * 32 + (lane & 31), wb + WO_D, nb * 32, kb * 64, scr, lane); }
    }
}

__device__ __forceinline__ void rownorm_phase(const float* X, const float* g, bf16_t* Hout, int gw, int ngw, int lane) {
    f32x4 gv[4];
#pragma unroll
    for (int j = 0; j < 4; ++j) gv[j] = *(const f32x4*)(g + 4 * lane + 256 * j);
    for (int row = gw; row < T; row += ngw) {
        const float* xr = X + (size_t)row * DM + 4 * lane; f32x4 v[4]; float s = 0.f;
#pragma unroll
        for (int j = 0; j < 4; ++j) { v[j] = *(const f32x4*)(xr + 256 * j); s += (v[j][0] * v[j][0] + v[j][1] * v[j][1]) + (v[j][2] * v[j][2] + v[j][3] * v[j][3]); }
        const float rs = 1.0f / sqrtf(wave_sum(s) * (1.0f / DM) + RMS_EPS);
        bf16_t* hr = Hout + (size_t)row * DM + 4 * lane;
#pragma unroll
        for (int j = 0; j < 4; ++j) { const f32x4 o = v[j] * rs * gv[j]; u32x2 w; w.x = cvt_pk_bf16(o[0], o[1]); w.y = cvt_pk_bf16(o[2], o[3]); *(u32x2*)(hr + 256 * j) = w; }
    }
}
template <bool HASH>
__device__ __forceinline__ void rowpass_phase(const float* Y, const float* xbase, float* xout, bf16_t* Hout, const float* gpost, const float* gpre, int gw, int ngw, int lane) {
    f32x4 gp[4], gq[4];
#pragma unroll
    for (int j = 0; j < 4; ++j) { gp[j] = *(const f32x4*)(gpost + 4 * lane + 256 * j); gq[j] = HASH ? *(const f32x4*)(gpre + 4 * lane + 256 * j) : (f32x4){0.f, 0.f, 0.f, 0.f}; }
    for (int row = gw; row < T; row += ngw) {
        const size_t ro = (size_t)row * DM + 4 * lane;
        f32x4 y[4], x[4]; float s = 0.f;
#pragma unroll
        for (int j = 0; j < 4; ++j) { y[j] = *(const f32x4*)(Y + ro + 256 * j); x[j] = *(const f32x4*)(xbase + ro + 256 * j); s += (y[j][0] * y[j][0] + y[j][1] * y[j][1]) + (y[j][2] * y[j][2] + y[j][3] * y[j][3]); }
        const float rs = 1.0f / sqrtf(wave_sum(s) * (1.0f / DM) + RMS_EPS);
        float s2 = 0.f;
#pragma unroll
        for (int j = 0; j < 4; ++j) { x[j] = x[j] + y[j] * rs * gp[j]; *(f32x4*)(xout + ro + 256 * j) = x[j]; s2 += (x[j][0] * x[j][0] + x[j][1] * x[j][1]) + (x[j][2] * x[j][2] + x[j][3] * x[j][3]); }
        if (HASH) {
            const float rs2 = 1.0f / sqrtf(wave_sum(s2) * (1.0f / DM) + RMS_EPS);
#pragma unroll
            for (int j = 0; j < 4; ++j) { const f32x4 o = x[j] * rs2 * gq[j]; u32x2 w; w.x = cvt_pk_bf16(o[0], o[1]); w.y = cvt_pk_bf16(o[2], o[3]); *(u32x2*)(Hout + ro + 256 * j) = w; }
        }
    }
}

__device__ __forceinline__ void sincos_d(double x, double& s, double& c) {
    const double TWO_PI = 6.283185307179586476925286766559, INV_TWO_PI = 0.15915494309189533576888376337251;
    const double k = __builtin_rint(x * INV_TWO_PI); const double r = x - k * TWO_PI; const double r2 = r * r;
    double ts = 1.0, tc = 1.0;
#pragma unroll
    for (int i = 15; i >= 1; --i) { ts = 1.0 - ts * r2 / (double)((2 * i) * (2 * i + 1)); tc = 1.0 - tc * r2 / (double)((2 * i - 1) * (2 * i)); }
    s = ts * r; c = tc;
}
__device__ __forceinline__ void rope_table_phase(float* tab, int gt, int ngt) {
    for (int idx = gt; idx < SEQ * 8; idx += ngt) {
        const int pos = idx >> 3, i = idx & 7;
        float inv;
        switch (i) { case 0: inv = 1.0f; break; case 1: inv = 0.1939227432012558f; break; case 2: inv = 0.03760603070259094f; break; case 3: inv = 0.007292664609849453f; break;
                     case 4: inv = 0.0014142135623842478f; break; case 5: inv = 0.00027424818836152554f; break; case 6: inv = 5.318296098266728e-05f; break; default: inv = 1.0313386155758053e-05f; break; }
        const float ang = (float)pos * inv; double s, c; sincos_d((double)ang, s, c);
        tab[pos * 16 + i] = (float)c; tab[pos * 16 + 8 + i] = (float)s;
    }
}

constexpr int AT_KP = 144, AT_VP = 776, AT_KOFF = 0, AT_VOFF = 384 * AT_KP;
static_assert(AT_VOFF + 64 * AT_VP <= LDS_BYTES, "attention LDS");
template <int NX>
__device__ __forceinline__ void att_tile(LAS const unsigned char* kl, LAS const unsigned char* vl, const bf16x8 (&qr)[4], int jb, bool domask, int lo, unsigned range, int r, int h,
                                         float& m, float& l, f32x16& o0, f32x16& o1) {
    f32x16 p[2];
#pragma unroll
    for (int x = 0; x < NX; ++x) {
        LAS const unsigned char* kp = kl + (jb + 32 * x + r) * AT_KP + h * 16;
        f32x16 a = {};
#pragma unroll
        for (int d0 = 0; d0 < 4; ++d0) { const bf16x8 kf = *(LAS const bf16x8*)(kp + d0 * 32); a = __builtin_amdgcn_mfma_f32_32x32x16_bf16(kf, qr[d0], a, 0, 0, 0); }
        p[x] = a;
    }
    if (domask) {
        const int t = jb + 4 * h - lo;
#pragma unroll
        for (int x = 0; x < NX; ++x)
#pragma unroll
            for (int reg = 0; reg < 16; ++reg) { const int cst = 32 * x + (reg & 3) + 8 * (reg >> 2); if ((unsigned)(t + cst) > range) p[x][reg] = -INFINITY; }
    }
    float mx = p[0][0];
#pragma unroll
    for (int x = 0; x < NX; ++x)
#pragma unroll
        for (int reg = 0; reg < 16; ++reg) mx = fmaxf(mx, p[x][reg]);
    mx = fmaxf(mx, __shfl_xor(mx, 32));
    const float mn = fmaxf(m, mx);
    const float alpha = __builtin_amdgcn_exp2f(m - mn);
    m = mn; l *= alpha;
#pragma unroll
    for (int reg = 0; reg < 16; ++reg) { o0[reg] *= alpha; o1[reg] *= alpha; }
    float ls = 0.f;
#pragma unroll
    for (int x = 0; x < NX; ++x)
#pragma unroll
        for (int reg = 0; reg < 16; ++reg) { p[x][reg] = __builtin_amdgcn_exp2f(p[x][reg] - mn); ls += p[x][reg]; }
    l += ls;
#pragma unroll
    for (int x = 0; x < NX; ++x)
#pragma unroll
        for (int s = 0; s < 2; ++s) {
            u32x4 pw; pw.x = cvt_pk_bf16(p[x][8 * s + 0], p[x][8 * s + 1]); pw.y = cvt_pk_bf16(p[x][8 * s + 2], p[x][8 * s + 3]);
            pw.z = cvt_pk_bf16(p[x][8 * s + 4], p[x][8 * s + 5]); pw.w = cvt_pk_bf16(p[x][8 * s + 6], p[x][8 * s + 7]);
            const bf16x8 pf = __builtin_bit_cast(bf16x8, pw);
            LAS const unsigned char* vp = vl + r * AT_VP + (jb + 32 * x + 16 * s + 4 * h) * 2;
            { const u32x2 a = *(LAS const u32x2*)vp, b = *(LAS const u32x2*)(vp + 16); const u32x4 vw = (u32x4){a.x, a.y, b.x, b.y};
              o0 = __builtin_amdgcn_mfma_f32_32x32x16_bf16(__builtin_bit_cast(bf16x8, vw), pf, o0, 0, 0, 0); }
            { const u32x2 a = *(LAS const u32x2*)(vp + 32 * AT_VP), b = *(LAS const u32x2*)(vp + 32 * AT_VP + 16); const u32x4 vw = (u32x4){a.x, a.y, b.x, b.y};
              o1 = __builtin_amdgcn_mfma_f32_32x32x16_bf16(__builtin_bit_cast(bf16x8, vw), pf, o1, 0, 0, 0); }
        }
}
__device__ __forceinline__ void attn_unit(LAS unsigned char* lds, bf16_t* Q, const bf16_t* Kb, const bf16_t* Vb, const float* sink, int b, int kvh, int qb, int tid) {
    const int lane = tid & 63, w = __builtin_amdgcn_readfirstlane(tid >> 6), r = lane & 31, h = lane >> 5;
    const int q0 = qb * 128, ks = q0 - 128;
    {
        u32x4 kv[6], vv[6];
#pragma unroll
        for (int i = 0; i < 6; ++i) { const int chunk = tid + 512 * i, j = chunk >> 3, dch = chunk & 7, key = ks + j;
            kv[i] = (u32x4){0u, 0u, 0u, 0u}; vv[i] = (u32x4){0u, 0u, 0u, 0u};
            if (key >= 0 && key < SEQ) { const size_t g = ((size_t)(b * SEQ + key)) * 256 + kvh * 64 + dch * 8; kv[i] = *(const u32x4*)(Kb + g); vv[i] = *(const u32x4*)(Vb + g); } }
#pragma unroll
        for (int i = 0; i < 6; ++i) { const int chunk = tid + 512 * i, j = chunk >> 3, dch = chunk & 7;
            *(LAS u32x4*)(lds + AT_KOFF + j * AT_KP + dch * 16) = kv[i];
            LAS unsigned short* vt = (LAS unsigned short*)(lds + AT_VOFF + (dch * 8) * AT_VP + j * 2);
            vt[0 * (AT_VP / 2)] = (unsigned short)(vv[i].x & 0xffffu); vt[1 * (AT_VP / 2)] = (unsigned short)(vv[i].x >> 16);
            vt[2 * (AT_VP / 2)] = (unsigned short)(vv[i].y & 0xffffu); vt[3 * (AT_VP / 2)] = (unsigned short)(vv[i].y >> 16);
            vt[4 * (AT_VP / 2)] = (unsigned short)(vv[i].z & 0xffffu); vt[5 * (AT_VP / 2)] = (unsigned short)(vv[i].z >> 16);
            vt[6 * (AT_VP / 2)] = (unsigned short)(vv[i].w & 0xffffu); vt[7 * (AT_VP / 2)] = (unsigned short)(vv[i].w >> 16); }
    }
    __syncthreads();
    const int hq = kvh * 4 + (w >> 1);
    const float snk = sink[hq] * LOG2E;
    LAS const unsigned char* kl = lds + AT_KOFF; LAS const unsigned char* vl = lds + AT_VOFF;
    const bool edge = (qb == 0) || (qb == SEQ / 128 - 1);
    for (int rbi = 0; rbi < 2; ++rbi) {
        const int r0 = ((w & 1) * 2 + rbi) * 32;
        bf16_t* qrow = Q + ((size_t)(b * SEQ + q0 + r0 + r)) * 1024 + hq * 64;
        bf16x8 qr[4];
#pragma unroll
        for (int d0 = 0; d0 < 4; ++d0) qr[d0] = *(const bf16x8*)(qrow + 16 * d0 + 8 * h);
        float m = snk, l = (h == 0) ? 1.0f : 0.0f; f32x16 o0 = {}, o1 = {};
        const int jq = r0 + r;
        const int lo = max(jq, 128 - q0), hi = min(jq + 256, SEQ - 1 - q0 + 128);
        const unsigned range = (unsigned)(hi - lo);
        att_tile<2>(kl, vl, qr, r0, true, lo, range, r, h, m, l, o0, o1);
        att_tile<2>(kl, vl, qr, r0 + 64, edge, lo, range, r, h, m, l, o0, o1);
        att_tile<2>(kl, vl, qr, r0 + 128, edge, lo, range, r, h, m, l, o0, o1);
        att_tile<2>(kl, vl, qr, r0 + 192, edge, lo, range, r, h, m, l, o0, o1);
        att_tile<1>(kl, vl, qr, r0 + 256, true, lo, range, r, h, m, l, o0, o1);
        const float lt = l + __shfl_xor(l, 32); const float inv = 1.0f / lt;
#pragma unroll
        for (int g = 0; g < 4; ++g) {
            u32x2 w0, w1;
            w0.x = cvt_pk_bf16(o0[4 * g] * inv, o0[4 * g + 1] * inv); w0.y = cvt_pk_bf16(o0[4 * g + 2] * inv, o0[4 * g + 3] * inv);
            w1.x = cvt_pk_bf16(o1[4 * g] * inv, o1[4 * g + 1] * inv); w1.y = cvt_pk_bf16(o1[4 * g + 2] * inv, o1[4 * g + 3] * inv);
            *(u32x2*)(qrow + 8 * g + 4 * h) = w0; *(u32x2*)(qrow + 32 + 8 * g + 4 * h) = w1;
        }
    }
    __syncthreads();
}
__device__ __forceinline__ void conv_phase(bf16_t* CB, const bf16_t* U, const float* cw, int gw, int ngw, int lane) {
    for (int run = gw; run < (T / 16) * 2; run += ngw) {
        const int half = run & 1, row0 = (run >> 1) * 16, col = half * 512 + lane * 8, t0 = row0 & (SEQ - 1);
        float w0[8], w1[8], w2[8];
#pragma unroll
        for (int e = 0; e < 8; ++e) { w0[e] = cw[col + e]; w1[e] = cw[1024 + col + e]; w2[e] = cw[2048 + col + e]; }
        u32x4 up = (u32x4){0u, 0u, 0u, 0u}, uc, un;
        if (t0 > 0) up = *(const u32x4*)(U + (size_t)(row0 - 1) * 1024 + col);
        uc = *(const u32x4*)(U + (size_t)row0 * 1024 + col);
#pragma unroll 4
        for (int i = 0; i < 16; ++i) {
            const int row = row0 + i;
            un = (u32x4){0u, 0u, 0u, 0u};
            if (t0 + i + 1 < SEQ) un = *(const u32x4*)(U + (size_t)(row + 1) * 1024 + col);
            const u32x4 cbw = *(const u32x4*)(CB + (size_t)row * 1024 + col);
            u32x4 o;
#pragma unroll
            for (int e = 0; e < 4; ++e) {
                const float a = bf_lo(cbw[e]) * (w0[2 * e] * bf_lo(up[e]) + w1[2 * e] * bf_lo(uc[e]) + w2[2 * e] * bf_lo(un[e]));
                const float b = bf_hi(cbw[e]) * (w0[2 * e + 1] * bf_hi(up[e]) + w1[2 * e + 1] * bf_hi(uc[e]) + w2[2 * e + 1] * bf_hi(un[e]));
                o[e] = cvt_pk_bf16(a, b);
            }
            *(u32x4*)(CB + (size_t)row * 1024 + col) = o;
            up = uc; uc = un;
        }
    }
}

#define LAYER_W(l) in2 + (size_t)(l) * DM * INC, in5 + (size_t)(l) * DM * DM, in6 + (size_t)(l) * DM * DM, in7 + (size_t)(l) * DM * DM, in10 + (size_t)(l) * DM * DFF, in11 + (size_t)(l) * DM * DFF, in12 + (size_t)(l) * DFF * DM
__global__ void __launch_bounds__(NTHREADS, 2) fwd(const float* __restrict__ in0, const float* __restrict__ in1, const float* __restrict__ in2, const float* __restrict__ in3, const float* __restrict__ in4,
        const float* __restrict__ in5, const float* __restrict__ in6, const float* __restrict__ in7, const float* __restrict__ in8, const float* __restrict__ in9, const float* __restrict__ in10,
        const float* __restrict__ in11, const float* __restrict__ in12, const float* __restrict__ in13, float* out, unsigned char* wsp, int ph_lo, int ph_hi) {
    extern __shared__ __attribute__((aligned(16))) unsigned char lds_raw[];
    LAS unsigned char* lds = (LAS unsigned char*)lds_raw;
    cg::grid_group grid = cg::this_grid();
    for (int ph = ph_lo; ph < ph_hi; ++ph) {
        int tid = threadIdx.x; asm volatile("" : "+v"(tid));
        const int lane = tid & 63, wave = __builtin_amdgcn_readfirstlane(tid >> 6);
        int G = gridDim.x, bx = blockIdx.x; asm volatile("" : "+s"(G), "+s"(bx));
        const int gw = bx * NWAVES + wave, ngw = G * NWAVES;
        size_t zoff = 0; asm volatile("" : "+s"(zoff));
        unsigned char* ws = wsp + zoff;
        float* rope = (float*)(ws + WS_ROPE);
        bf16_t* Hb = (bf16_t*)(ws + WS_H);
        unsigned char* Z = ws + WS_Z;
        bf16_t *Qb = (bf16_t*)(Z + ZQ), *Kb = (bf16_t*)(Z + ZK), *Vb = (bf16_t*)(Z + ZV), *CBb = (bf16_t*)(Z + ZCB), *Ub = (bf16_t*)(Z + ZU), *SGAb = (bf16_t*)(Z + ZSGA), *SGBb = (bf16_t*)(Z + ZSGB);
        float* Yb = (float*)(Z + ZY); bf16_t* ACTb = (bf16_t*)(Z + ZACT);
        float* xout = out + zoff;
        if (ph == 0) {
            convert_layer(LAYER_W(0), (bf16_t*)(ws + WS_W0), lds, gw, ngw, wave, lane);
            rope_table_phase(rope, bx * NTHREADS + tid, G * NTHREADS);
            rownorm_phase(in0 + zoff, in1, Hb, gw, ngw, lane);
        } else {
            const int l = (ph - 1) >> 3, s = (ph - 1) & 7;
            const bf16_t* wb = (const bf16_t*)(ws + WS_W0 + (size_t)(l & 1) * WS_WSTRIDE);
            if (s == 0) {
                pg8::SchedG S; S.o.init(T, INC, G, bx); S.A = (const char*)Hb; S.Bt = (const char*)(wb + WO_IN); S.ta = (size_t)256 * DM * 2; S.tb = (size_t)256 * DM * 2;
                EpiIn E{Qb, Kb, Vb, CBb, Ub, SGAb, SGBb, rope};
                pg8::gemm_phase<EpiIn, pg8::SchedG, true, true>(lds, tid, DM, S, E);
            } else if (s == 1) {
                const float* sink = in3 + l * NH;
                for (int unit = bx; unit < BATCH * NKV * (SEQ / 128); unit += G) {
                    const int qb = unit & 31, kvh = (unit >> 5) & 3, b = unit >> 7;
                    attn_unit(lds, Qb, Kb, Vb, sink, b, kvh, qb, tid);
                }
                conv_phase(CBb, Ub, in4 + (size_t)l * 3 * DM, gw, ngw, lane);
            } else if (s == 2) {
                pg8::SchedPair S; S.o.init(T, DM, G, bx); S.A0 = (const char*)Qb; S.A1 = (const char*)CBb; S.B0 = (const char*)(wb + WO_A); S.B1 = (const char*)(wb + WO_C);
                S.ta = (size_t)256 * DM * 2; S.tb = (size_t)256 * DM * 2;
                EpiMix E{SGAb, SGBb, Hb};
                pg8::gemm_phase<EpiMix, pg8::SchedPair, true, true>(lds, tid, DM, S, E);
            } else if (s == 3 || s == 6) {
                pg8::SchedG S; S.o.init(T, DM, G, bx);
                const int K = (s == 3) ? DM : DFF;
                S.A = (s == 3) ? (const char*)Hb : (const char*)ACTb; S.Bt = (const char*)(wb + ((s == 3) ? WO_O : WO_D)); S.ta = (size_t)256 * K * 2; S.tb = (size_t)256 * K * 2;
                EpiF32 E{Yb};
                pg8::gemm_phase<EpiF32, pg8::SchedG, true, true>(lds, tid, K, S, E);
            } else if (s == 4) {
                rowpass_phase<true>(Yb, (l == 0) ? in0 : (const float*)xout, xout, Hb, in8 + l * DM, in9 + l * DM, gw, ngw, lane);
                if (l + 1 < DEPTH) convert_layer(LAYER_W(l + 1), (bf16_t*)(ws + WS_W0 + (size_t)((l + 1) & 1) * WS_WSTRIDE), lds, gw, ngw, wave, lane);
            } else if (s == 5) {
                pg8::SchedG S; S.o.init(T, NGU, G, bx); S.A = (const char*)Hb; S.Bt = (const char*)(wb + WO_GU); S.ta = (size_t)256 * DM * 2; S.tb = (size_t)256 * DM * 2;
                EpiAct E{ACTb};
                pg8::gemm_phase<EpiAct, pg8::SchedG, true, true>(lds, tid, DM, S, E);
            } else {
                if (l + 1 < DEPTH) rowpass_phase<true>(Yb, xout, xout, Hb, in13 + l * DM, in1 + (l + 1) * DM, gw, ngw, lane);
                else rowpass_phase<false>(Yb, xout, xout, Hb, in13 + l * DM, in1, gw, ngw, lane);
            }
        }
        if (ph + 1 < ph_hi) grid.sync();
    }
}

extern "C" void kernel_launch(void* const* d_in, const int* in_sizes, int n_in, void* d_out, int out_size, void* d_ws, size_t ws_size, hipStream_t stream) {
    static int grid = 0;
    if (grid == 0) {
        if (n_in != 14 || in_sizes[0] != T * DM || out_size != T * DM || ws_size < WS_END) { fprintf(stderr, "kernel_launch: unexpected shapes / workspace (%d inputs, ws %zu)\n", n_in, ws_size); grid = -1; return; }
        int dev = 0, cus = 0, per_cu = 0;
        if (hipGetDevice(&dev) != hipSuccess || hipDeviceGetAttribute(&cus, hipDeviceAttributeMultiprocessorCount, dev) != hipSuccess) { grid = -1; return; }
        if (hipFuncSetAttribute((const void*)fwd, hipFuncAttributeMaxDynamicSharedMemorySize, LDS_BYTES) != hipSuccess) { fprintf(stderr, "kernel_launch: hipFuncSetAttribute failed\n"); grid = -1; return; }
        if (hipOccupancyMaxActiveBlocksPerMultiprocessor(&per_cu, (const void*)fwd, NTHREADS, LDS_BYTES) != hipSuccess || per_cu < 1) { fprintf(stderr, "kernel_launch: occupancy query failed (%d)\n", per_cu); (void)hipGetLastError(); per_cu = 1; }
        grid = cus * per_cu;
    }
    if (grid < 0) return;
    const float* in[14];
    for (int i = 0; i < 14; ++i) in[i] = (const float*)d_in[i];
    float* outp = (float*)d_out; unsigned char* wsp = (unsigned char*)d_ws;
#if MK_MULTI
    for (int ph = 0; ph < NPHASES; ++ph)
        hipLaunchKernelGGL(fwd, dim3(grid), dim3(NTHREADS), LDS_BYTES, stream, in[0], in[1], in[2], in[3], in[4], in[5], in[6], in[7], in[8], in[9], in[10], in[11], in[12], in[13], outp, wsp, ph, ph + 1);
#else
    int ph_lo = 0, ph_hi = NPHASES;
    void* args[] = {&in[0], &in[1], &in[2], &in[3], &in[4], &in[5], &in[6], &in[7], &in[8], &in[9], &in[10], &in[11], &in[12], &in[13], &outp, &wsp, &ph_lo, &ph_hi};
    hipError_t e = hipLaunchCooperativeKernel((const void*)fwd, dim3(grid), dim3(NTHREADS), args, LDS_BYTES, stream);
    if (e != hipSuccess) fprintf(stderr, "kernel_launch: cooperative launch failed: %s (grid %d)\n", hipGetErrorString(e), grid);
#endif
}
```

```cpp
#include <hip/hip_runtime.h>
#include <hip/hip_cooperative_groups.h>
#include <cstdio>
#include <cstdint>
namespace cg = cooperative_groups;

#ifndef PROBE_TAB
#define PROBE_TAB 0x76543210ull
#define PROBE_N 8
#endif
#ifndef PROBE_SYNC2
#define PROBE_SYNC2 0
#endif
#ifndef PROBE_PART
#define PROBE_PART 3
#endif
#ifndef MK_MULTI
#define MK_MULTI 0
#endif

#define LAS __attribute__((address_space(3)))
typedef unsigned short bf16_t;
typedef short bf16x8 __attribute__((ext_vector_type(8)));
typedef float f32x4 __attribute__((ext_vector_type(4)));
typedef float f32x16 __attribute__((ext_vector_type(16)));
typedef unsigned u32x4 __attribute__((ext_vector_type(4)));
typedef unsigned u32x2 __attribute__((ext_vector_type(2)));

constexpr int BATCH = 8, SEQ = 4096, DM = 1024, DEPTH = 4, NH = 16, HD = 64, NKV = 4, DFF = 2816;
constexpr int T = BATCH * SEQ;
constexpr int INC = 6656;
constexpr int NGU = 2 * DFF;
constexpr float RMS_EPS = 1e-6f;
constexpr float LOG2E = 1.4426950408889634f;
constexpr float QSCALE = 0.125f * LOG2E;
constexpr int NWAVES = 8, NTHREADS = 512;
constexpr int LDS_MISC = 131072;
constexpr int LDS_BYTES = 131072 + 256;
constexpr int NPHASES = 1 + PROBE_N * DEPTH;

constexpr size_t MiB = 1u << 20;
constexpr size_t WS_BAR = 512 * 1024, WS_BAR_BYTES = 16384;
constexpr size_t WS_ROPE = 0;
constexpr size_t WS_W0 = 1 * MiB, WS_WSTRIDE = 36 * MiB;
constexpr size_t WS_H = 73 * MiB;
constexpr size_t WS_Z = 137 * MiB;
constexpr size_t ZQ = 0, ZK = 64 * MiB, ZV = 80 * MiB, ZCB = 96 * MiB, ZU = 160 * MiB, ZSGA = 224 * MiB, ZSGB = 288 * MiB;
constexpr size_t ZY = 0, ZACT = 128 * MiB;
constexpr size_t WS_END = WS_Z + 352 * MiB;
constexpr size_t WO_IN = 0, WO_A = (size_t)INC * DM, WO_C = WO_A + (size_t)DM * DM, WO_O = WO_C + (size_t)DM * DM,
                 WO_GU = WO_O + (size_t)DM * DM, WO_D = WO_GU + (size_t)NGU * DM, WO_END = WO_D + (size_t)DM * DFF;
static_assert(WO_END * 2 <= WS_WSTRIDE, "weight buffer");
static_assert(ZACT + (size_t)T * DFF * 2 <= 352 * MiB, "act overlay");

typedef float f32x2_t __attribute__((ext_vector_type(2))); typedef __bf16 bf16x2_t __attribute__((ext_vector_type(2)));
__device__ __forceinline__ unsigned cvt_pk_bf16(float lo, float hi) { const f32x2_t v = {lo, hi}; const bf16x2_t b = __builtin_convertvector(v, bf16x2_t); return __builtin_bit_cast(unsigned, b); }
__device__ __forceinline__ float bf_lo(unsigned u) { return __uint_as_float(u << 16); }
__device__ __forceinline__ float bf_hi(unsigned u) { return __uint_as_float(u & 0xffff0000u); }
__device__ __forceinline__ float fast_sigmoid(float g) { return __builtin_amdgcn_rcpf(1.0f + __builtin_amdgcn_exp2f(-g * LOG2E)); }
__device__ __forceinline__ float wave_sum(float v) {
#pragma unroll
    for (int o = 1; o < 64; o <<= 1) v += __shfl_xor(v, o);
    return v;
}

namespace pg8 {
constexpr int BM = 256, BK = 64, HALF = 128, HTB = HALF * BK * 2, STAGE_BYTES = 8 * HTB, NXCD = 8, WGM = 8;
__host__ __device__ __forceinline__ int lds_byte(int r, int c) { const int st = (r >> 4) * 2 + (c >> 5), rr = r & 15, cc = c & 31, ob = rr * 64 + cc * 2; return st * 1024 + (ob ^ (((ob >> 9) & 1) << 5)); }
__host__ __device__ __forceinline__ void stage_rc(int b, int& R, int& C) { const int st = b / 1024, sb = b % 1024, swz = sb ^ (((sb >> 9) & 1) << 5); R = (st >> 1) * 16 + swz / 64; C = (st & 1) * 32 + (swz % 64) / 2; }
__host__ __device__ __forceinline__ int perm32(int rho) { const int n = rho >> 4, i = rho & 15; return 8 * (i >> 2) + 4 * n + (i & 3); }

struct Unit { int pm, pn, kind; };
struct Order {
    int nM, nN, nwg, G, c;
    __device__ void init(int M, int N, int G_, int c_) { nM = M / BM; nN = N / BM; nwg = nM * nN; G = G_; c = c_; }
    __device__ bool tile(long L, int& pm, int& pn) const {
        if (L >= nwg) return false;
        int wgid = (int)L; { const int q = nwg / NXCD, r = nwg % NXCD, xcd = wgid % NXCD, off = wgid / NXCD; wgid = (xcd < r ? xcd * (q + 1) : r * (q + 1) + (xcd - r) * q) + off; }
        const int nig = WGM * nN, gid = wgid / nig, fm = gid * WGM, gsz = (nM - fm) < WGM ? (nM - fm) : WGM;
        pm = fm + ((wgid % nig) % gsz); pn = (wgid % nig) / gsz; return true;
    }
};
struct SchedG {
    Order o; const char* A; const char* Bt; size_t ta, tb;
    __device__ __forceinline__ bool next(int i, Unit& u) const { u.kind = 0; return o.tile((long)i * o.G + o.c, u.pm, u.pn); }
    __device__ __forceinline__ const char* aptr(const Unit& u) const { return A + (size_t)u.pm * ta; }
    __device__ __forceinline__ const char* bptr(const Unit& u) const { return Bt + (size_t)u.pn * tb; }
    __device__ __forceinline__ bool keep(const Unit&) const { return false; }
};
struct SchedPair {
    Order o; const char* A0; const char* A1; const char* B0; const char* B1; size_t ta, tb;
    __device__ __forceinline__ bool next(int i, Unit& u) const { u.kind = i & 1; return o.tile((long)(i >> 1) * o.G + o.c, u.pm, u.pn); }
    __device__ __forceinline__ const char* aptr(const Unit& u) const { return (u.kind ? A1 : A0) + (size_t)u.pm * ta; }
    __device__ __forceinline__ const char* bptr(const Unit& u) const { return (u.kind ? B1 : B0) + (size_t)u.pn * tb; }
    __device__ __forceinline__ bool keep(const Unit& u) const { return u.kind == 0; }
};

template <class Epi, class Sched, bool ALIGN_EPI, bool SP2>
__device__ __forceinline__ void gemm_phase(LAS unsigned char* lds, const int tid, const int K, const Sched& S, const Epi& E) {
    const int wid = __builtin_amdgcn_readfirstlane(tid >> 6), lane = tid & 63, wr = wid >> 2, wc = wid & 3, fr = lane & 15, fq = lane >> 4;
    const int nt = K / BK;
    unsigned voffA[2], voffB[2];
#pragma unroll
    for (int i = 0; i < 2; ++i) { int R, C; stage_rc(tid * 16 + i * 8192, R, C); const int Rb = Epi::PERM ? ((R & ~31) + perm32(R & 31)) : R;
        voffA[i] = (unsigned)(R * K + C) * 2u; voffB[i] = (unsigned)(Rb * K + C) * 2u; }
    const size_t kstep = (size_t)(BK * 2);
    const size_t hstep = (size_t)HALF * K * 2;
    const unsigned ldsw = (unsigned)wid * 1024u;
    const int aoff = lds_byte(wr * 64 + fr, fq * 8), boff = lds_byte(wc * 32 + fr, fq * 8);
#define PG8_SA(b, h) (((b) * 2 + (h)) * HTB)
#define PG8_SB(b, h) ((4 + (b) * 2 + (h)) * HTB)
#define PG8_STAGE(bufoff, gbase, voff) do { _Pragma("unroll") for (int _i = 0; _i < 2; ++_i) \
        __builtin_amdgcn_global_load_lds((const unsigned*)((const char*)(gbase) + (voff)[_i]), (LAS unsigned*)(lds + (bufoff) + ldsw + _i * 8192), 16, 0, 0); } while (0)
#define PG8_LDA(dst, b, h) do { _Pragma("unroll") for (int m = 0; m < 4; ++m) _Pragma("unroll") for (int k = 0; k < 2; ++k) dst[m][k] = *(const LAS bf16x8*)(lds + PG8_SA(b, h) + aoff + m * 2048 + k * 1024); } while (0)
#define PG8_LDB(dst, b, h) do { _Pragma("unroll") for (int n = 0; n < 2; ++n) _Pragma("unroll") for (int k = 0; k < 2; ++k) dst[n][k] = *(const LAS bf16x8*)(lds + PG8_SB(b, h) + boff + n * 2048 + k * 1024); } while (0)
#define PG8_MMA(ai, bj, At, Bt) do { __builtin_amdgcn_s_setprio(1); _Pragma("unroll") for (int m = 0; m < 4; ++m) _Pragma("unroll") for (int n = 0; n < 2; ++n) _Pragma("unroll") for (int k = 0; k < 2; ++k) \
        acc[ai][bj][m][n] = __builtin_amdgcn_mfma_f32_16x16x32_bf16(Bt[n][k], At[m][k], acc[ai][bj][m][n], 0, 0, 0); __builtin_amdgcn_s_setprio(0); } while (0)
#define PG8_WAIT_V(n) asm volatile("s_waitcnt vmcnt(" #n ")" ::: "memory")
#define PG8_WAIT_L(n) asm volatile("s_waitcnt lgkmcnt(" #n ")" ::: "memory")
#define PG8_BAR __builtin_amdgcn_s_barrier()
#define PG8_SCHED __builtin_amdgcn_sched_barrier(0)
    Unit cur, nxt; int ui = 0;
    if (!S.next(0, cur)) return;
    f32x4 acc[2][2][4][2];
#pragma unroll
    for (int a = 0; a < 2; ++a)
#pragma unroll
        for (int b = 0; b < 2; ++b)
#pragma unroll
            for (int m = 0; m < 4; ++m)
#pragma unroll
                for (int n = 0; n < 2; ++n) acc[a][b][m][n] = (f32x4){0.f, 0.f, 0.f, 0.f};
    bf16x8 At[4][2], B0[2][2], B1[2][2];
    const char* cA = S.aptr(cur); const char* cB = S.bptr(cur);
    if constexpr (SP2) {
        PG8_STAGE(PG8_SB(0, 0), cB, voffB); PG8_STAGE(PG8_SB(0, 1), cB + hstep, voffB); PG8_STAGE(PG8_SA(0, 0), cA, voffA); PG8_STAGE(PG8_SA(0, 1), cA + hstep, voffA);
        if (wr == 1) PG8_BAR;
        PG8_WAIT_V(2); PG8_BAR;
        PG8_STAGE(PG8_SB(1, 0), cB + kstep, voffB); PG8_STAGE(PG8_SA(1, 0), cA + kstep, voffA); PG8_STAGE(PG8_SB(1, 1), cB + hstep + kstep, voffB);
        PG8_WAIT_V(6); PG8_BAR;
    } else {
        PG8_STAGE(PG8_SB(0, 0), cB, voffB); PG8_STAGE(PG8_SA(0, 0), cA, voffA); PG8_STAGE(PG8_SB(0, 1), cB + hstep, voffB); PG8_STAGE(PG8_SA(0, 1), cA + hstep, voffA);
        if (wr == 1) PG8_BAR;
        PG8_WAIT_V(4); PG8_BAR;
        PG8_STAGE(PG8_SB(1, 0), cB + kstep, voffB); PG8_STAGE(PG8_SA(1, 0), cA + kstep, voffA); PG8_STAGE(PG8_SB(1, 1), cB + hstep + kstep, voffB);
        PG8_WAIT_V(6); PG8_BAR;
    }
    for (;;) {
        const bool has_next = S.next(ui + 1, nxt);
        const char* nA = has_next ? S.aptr(nxt) : cA; const char* nB = has_next ? S.bptr(nxt) : cB;
        for (int t = 0; t < nt; t += 2) {
            const bool last = (t == nt - 2);
            const char* a1 = cA + (size_t)(t + 1) * kstep;
            const char* a2 = last ? nA : cA + (size_t)(t + 2) * kstep; const char* b2 = last ? nB : cB + (size_t)(t + 2) * kstep;
            const char* a3 = a2 + kstep; const char* b3 = b2 + kstep;
            if constexpr (SP2) {
            PG8_LDB(B0, 0, 0); PG8_LDB(B1, 0, 1); PG8_SCHED; PG8_LDA(At, 0, 0); PG8_STAGE(PG8_SA(1, 1), a1 + hstep, voffA);
            PG8_WAIT_V(8); PG8_WAIT_L(0); PG8_BAR; PG8_MMA(0, 0, At, B0); PG8_MMA(0, 1, At, B1); PG8_BAR; PG8_SCHED;
            PG8_LDA(At, 0, 1); PG8_STAGE(PG8_SB(0, 0), b2, voffB); PG8_STAGE(PG8_SB(0, 1), b2 + hstep, voffB); PG8_STAGE(PG8_SA(0, 0), a2, voffA);
            PG8_WAIT_V(8); PG8_WAIT_L(0); PG8_BAR; PG8_MMA(1, 0, At, B0); PG8_MMA(1, 1, At, B1); PG8_BAR; PG8_SCHED;
            PG8_LDB(B0, 1, 0); PG8_LDB(B1, 1, 1); PG8_SCHED; PG8_LDA(At, 1, 0); PG8_STAGE(PG8_SA(0, 1), a2 + hstep, voffA);
            PG8_WAIT_V(8); PG8_WAIT_L(0); PG8_BAR; PG8_MMA(0, 0, At, B0); PG8_MMA(0, 1, At, B1); PG8_BAR; PG8_SCHED;
            PG8_LDA(At, 1, 1); PG8_STAGE(PG8_SB(1, 0), b3, voffB); PG8_STAGE(PG8_SB(1, 1), b3 + hstep, voffB); PG8_STAGE(PG8_SA(1, 0), a3, voffA);
            PG8_WAIT_V(8); PG8_WAIT_L(0); PG8_BAR; PG8_MMA(1, 0, At, B0); PG8_MMA(1, 1, At, B1); PG8_BAR; PG8_SCHED;
            } else {
            PG8_LDB(B0, 0, 0); PG8_SCHED; PG8_LDA(At, 0, 0); PG8_STAGE(PG8_SA(1, 1), a1 + hstep, voffA);
            PG8_WAIT_L(8); PG8_BAR; PG8_WAIT_L(0); PG8_MMA(0, 0, At, B0); PG8_BAR; PG8_SCHED;
            PG8_LDB(B1, 0, 1); PG8_STAGE(PG8_SB(0, 0), b2, voffB);
            PG8_BAR; PG8_WAIT_L(0); PG8_MMA(0, 1, At, B1); PG8_BAR;
            PG8_LDA(At, 0, 1); PG8_STAGE(PG8_SA(0, 0), a2, voffA);
            PG8_BAR; PG8_WAIT_L(0); PG8_MMA(1, 0, At, B0); PG8_BAR; PG8_SCHED;
            PG8_STAGE(PG8_SB(0, 1), b2 + hstep, voffB);
            PG8_WAIT_V(6); PG8_BAR; PG8_MMA(1, 1, At, B1); PG8_BAR;
            PG8_LDB(B0, 1, 0); PG8_SCHED; PG8_LDA(At, 1, 0); PG8_STAGE(PG8_SA(0, 1), a2 + hstep, voffA);
            PG8_WAIT_L(8); PG8_BAR; PG8_WAIT_L(0); PG8_MMA(0, 0, At, B0); PG8_BAR; PG8_SCHED;
            PG8_LDB(B1, 1, 1); PG8_STAGE(PG8_SB(1, 0), b3, voffB);
            PG8_BAR; PG8_WAIT_L(0); PG8_MMA(0, 1, At, B1); PG8_BAR;
            PG8_LDA(At, 1, 1); PG8_STAGE(PG8_SA(1, 0), a3, voffA);
            PG8_BAR; PG8_WAIT_L(0); PG8_MMA(1, 0, At, B0); PG8_BAR; PG8_SCHED;
            PG8_STAGE(PG8_SB(1, 1), b3 + hstep, voffB);
            PG8_WAIT_V(6); PG8_BAR; PG8_MMA(1, 1, At, B1); PG8_BAR;
            }
        }
        if constexpr (ALIGN_EPI) { if (wr == 0) PG8_BAR; }
        E(acc, cur, wr, wc, fr, fq);
        if (!has_next) break;
        if (!S.keep(cur)) {
#pragma unroll
            for (int a = 0; a < 2; ++a)
#pragma unroll
                for (int b = 0; b < 2; ++b)
#pragma unroll
                    for (int m = 0; m < 4; ++m)
#pragma unroll
                        for (int n = 0; n < 2; ++n) acc[a][b][m][n] = (f32x4){0.f, 0.f, 0.f, 0.f};
        }
        cur = nxt; cA = nA; cB = nB; ++ui;
        if constexpr (ALIGN_EPI) { if (wr == 1) PG8_BAR; }
    }
    PG8_WAIT_V(0);
    if constexpr (!ALIGN_EPI) { if (wr == 0) PG8_BAR; }
    PG8_BAR;
#undef PG8_SA
#undef PG8_SB
#undef PG8_STAGE
#undef PG8_LDA
#undef PG8_LDB
#undef PG8_MMA
#undef PG8_WAIT_V
#undef PG8_WAIT_L
#undef PG8_BAR
#undef PG8_SCHED
}
}

typedef f32x4 Acc[2][2][4][2];
__device__ __forceinline__ void store8(bf16_t* p, const f32x4& v0, const f32x4& v1) {
    u32x4 w; w.x = cvt_pk_bf16(v0[0], v0[1]); w.y = cvt_pk_bf16(v0[2], v0[3]); w.z = cvt_pk_bf16(v1[0], v1[1]); w.w = cvt_pk_bf16(v1[2], v1[3]);
    *(u32x4*)p = w;
}
struct EpiIn {
    static constexpr bool PERM = true;
    bf16_t *Q, *Kb, *V, *CB, *U, *SGA, *SGB; const float* rope;
    __device__ __forceinline__ void operator()(Acc& acc, const pg8::Unit& u, int wr, int wc, int fr, int fq) const {
        const int row0 = u.pm * 256 + wr * 64 + fr, pn = u.pn, cl = wc * 32 + 8 * fq;
        if (pn <= 4) {
            const bool isq = pn < 4;
            bf16_t* base = isq ? Q + pn * 256 : Kb; const int ldc = isq ? 1024 : 256; const float sc = isq ? QSCALE : 1.0f;
            const bool wrope = ((wc & 1) == 0); const bool lrope = wrope && (fq < 2);
#pragma unroll
            for (int ai = 0; ai < 2; ++ai)
#pragma unroll
                for (int m = 0; m < 4; ++m) {
                    const int row = row0 + ai * 128 + m * 16;
                    f32x4 c4 = (f32x4){1.f, 1.f, 1.f, 1.f}, s4 = (f32x4){0.f, 0.f, 0.f, 0.f};
                    if (wrope) { const float* rp = rope + (size_t)(row & (SEQ - 1)) * 16 + 4 * (fq & 1); c4 = *(const f32x4*)rp; s4 = *(const f32x4*)(rp + 8); }
#pragma unroll
                    for (int bj = 0; bj < 2; ++bj) {
                        f32x4 v0 = acc[ai][bj][m][0], v1 = acc[ai][bj][m][1];
                        const f32x4 n0 = v0 * c4 - v1 * s4, n1 = v1 * c4 + v0 * s4;
                        if (lrope) { v0 = n0; v1 = n1; }
                        v0 *= sc; v1 *= sc;
                        store8(base + (size_t)row * ldc + bj * 128 + cl, v0, v1);
                    }
                }
        } else if (pn < 10) {
            bf16_t* base = (pn == 5) ? V : CB + (pn - 6) * 256; const int ldc = (pn == 5) ? 256 : 1024;
#pragma unroll
            for (int ai = 0; ai < 2; ++ai)
#pragma unroll
                for (int m = 0; m < 4; ++m) {
                    const int row = row0 + ai * 128 + m * 16;
#pragma unroll
                    for (int bj = 0; bj < 2; ++bj) store8(base + (size_t)row * ldc + bj * 128 + cl, acc[ai][bj][m][0], acc[ai][bj][m][1]);
                }
        } else if (pn < 18) {
            bf16_t* base = U + (pn - 10) * 128;
#pragma unroll
            for (int ai = 0; ai < 2; ++ai)
#pragma unroll
                for (int m = 0; m < 4; ++m) {
                    const int row = row0 + ai * 128 + m * 16;
                    store8(base + (size_t)row * 1024 + cl, acc[ai][0][m][0] * acc[ai][1][m][0], acc[ai][0][m][1] * acc[ai][1][m][1]);
                }
        } else {
            bf16_t* base = (pn < 22) ? SGA + (pn - 18) * 256 : SGB + (pn - 22) * 256;
#pragma unroll
            for (int ai = 0; ai < 2; ++ai)
#pragma unroll
                for (int m = 0; m < 4; ++m) {
                    const int row = row0 + ai * 128 + m * 16;
#pragma unroll
                    for (int bj = 0; bj < 2; ++bj) {
                        f32x4 v0 = acc[ai][bj][m][0], v1 = acc[ai][bj][m][1];
#pragma unroll
                        for (int j = 0; j < 4; ++j) { v0[j] = fast_sigmoid(v0[j]); v1[j] = fast_sigmoid(v1[j]); }
                        store8(base + (size_t)row * 1024 + bj * 128 + cl, v0, v1);
                    }
                }
        }
    }
};
struct EpiMix {
    static constexpr bool PERM = true;
    const bf16_t *SGA, *SGB; bf16_t* MIX;
    __device__ __forceinline__ void operator()(Acc& acc, const pg8::Unit& u, int wr, int wc, int fr, int fq) const {
        const int row0 = u.pm * 256 + wr * 64 + fr, col0 = u.pn * 256 + wc * 32 + 8 * fq;
#pragma unroll
        for (int ai = 0; ai < 2; ++ai)
#pragma unroll
            for (int m = 0; m < 4; ++m) {
                const int row = row0 + ai * 128 + m * 16;
#pragma unroll
                for (int bj = 0; bj < 2; ++bj) {
                    const size_t off = (size_t)row * 1024 + col0 + bj * 128;
                    const u32x4 sbw = *(const u32x4*)(SGB + off);
                    f32x4 b0, b1;
                    b0[0] = bf_lo(sbw.x); b0[1] = bf_hi(sbw.x); b0[2] = bf_lo(sbw.y); b0[3] = bf_hi(sbw.y);
                    b1[0] = bf_lo(sbw.z); b1[1] = bf_hi(sbw.z); b1[2] = bf_lo(sbw.w); b1[3] = bf_hi(sbw.w);
#pragma unroll
                    for (int j = 0; j < 4; ++j) { b0[j] = fmaxf(b0[j], 1e-30f); b1[j] = fmaxf(b1[j], 1e-30f); }
                    if (u.kind == 0) {
                        const u32x4 saw = *(const u32x4*)(SGA + off);
                        f32x4 a0, a1;
                        a0[0] = bf_lo(saw.x); a0[1] = bf_hi(saw.x); a0[2] = bf_lo(saw.y); a0[3] = bf_hi(saw.y);
                        a1[0] = bf_lo(saw.z); a1[1] = bf_hi(saw.z); a1[2] = bf_lo(saw.w); a1[3] = bf_hi(saw.w);
#pragma unroll
                        for (int j = 0; j < 4; ++j) { acc[ai][bj][m][0][j] *= a0[j] * __builtin_amdgcn_rcpf(b0[j]); acc[ai][bj][m][1][j] *= a1[j] * __builtin_amdgcn_rcpf(b1[j]); }
                    } else {
                        store8(MIX + off, acc[ai][bj][m][0] * b0, acc[ai][bj][m][1] * b1);
                    }
                }
            }
    }
};
struct EpiF32 {
    static constexpr bool PERM = false;
    float* Y;
    __device__ __forceinline__ void operator()(Acc& acc, const pg8::Unit& u, int wr, int wc, int fr, int fq) const {
        const int row0 = u.pm * 256 + wr * 64 + fr, col0 = u.pn * 256 + wc * 32 + 4 * fq;
#pragma unroll
        for (int ai = 0; ai < 2; ++ai)
#pragma unroll
            for (int m = 0; m < 4; ++m) { float* rowp = Y + (size_t)(row0 + ai * 128 + m * 16) * 1024 + col0;
#pragma unroll
                for (int bj = 0; bj < 2; ++bj)
#pragma unroll
                    for (int n = 0; n < 2; ++n) *(f32x4*)(rowp + bj * 128 + n * 16) = acc[ai][bj][m][n]; }
    }
};
struct EpiAct {
    static constexpr bool PERM = true;
    bf16_t* ACT;
    __device__ __forceinline__ void operator()(Acc& acc, const pg8::Unit& u, int wr, int wc, int fr, int fq) const {
        const int row0 = u.pm * 256 + wr * 64 + fr, col0 = u.pn * 128 + wc * 32 + 8 * fq;
#pragma unroll
        for (int ai = 0; ai < 2; ++ai)
#pragma unroll
            for (int m = 0; m < 4; ++m) {
                f32x4 v0, v1;
#pragma unroll
                for (int j = 0; j < 4; ++j) { const float g0 = acc[ai][0][m][0][j], g1 = acc[ai][0][m][1][j];
                    v0[j] = g0 * fast_sigmoid(g0) * acc[ai][1][m][0][j]; v1[j] = g1 * fast_sigmoid(g1) * acc[ai][1][m][1][j]; }
                store8(ACT + (size_t)(row0 + ai * 128 + m * 16) * DFF + col0, v0, v1);
            }
    }
};

__device__ __forceinline__ int qperm(int p) { return (p & 3) | ((p & 4) << 1) | ((p & 8) >> 1); }
__device__ __forceinline__ int win_src_col(int n) {
    if (n < 1280) { const int p = n & 63; return (n & ~63) + (p < 16 ? qperm(p) : p); }
    if (n < 2560) return n;
    if (n < 4608) { const int t = n - 2560, j = t >> 8, c = t & 255; return (c < 128) ? 2560 + 128 * j + c : 3584 + 128 * j + (c - 128); }
    return n;
}
__device__ __forceinline__ void transpose_item(const float* W, int K, int N, int srcc, bf16_t* WT, int n0, int k0, LAS float* scr, int lane) {
#pragma unroll 8
    for (int i = 0; i < 32; ++i) { const int kk = 2 * i + (lane >> 5); scr[kk * 33 + (lane & 31)] = W[(size_t)(k0 + kk) * N + srcc]; }
    asm volatile("s_waitcnt lgkmcnt(0)" ::: "memory");
    const int c = lane & 7;
#pragma unroll
    for (int j = 0; j < 4; ++j) { const int n = (lane >> 3) + 8 * j; const LAS float* s = scr + (8 * c) * 33 + n;
        u32x4 o; o.x = cvt_pk_bf16(s[0 * 33], s[1 * 33]); o.y = cvt_pk_bf16(s[2 * 33], s[3 * 33]); o.z = cvt_pk_bf16(s[4 * 33], s[5 * 33]); o.w = cvt_pk_bf16(s[6 * 33], s[7 * 33]);
        *(u32x4*)(WT + (size_t)(n0 + n) * K + k0 + 8 * c) = o; }
    asm volatile("s_waitcnt lgkmcnt(0)" ::: "memory");
}
__device__ __forceinline__ void convert_layer(const float* w_in, const float* w_attn, const float* w_conv, const float* w_out, const float* w_gate, const float* w_up, const float* w_down, bf16_t* wb, LAS unsigned char* lds, int gw, int ngw, int wave, int lane) {
    LAS float* scr = (LAS float*)(lds + wave * 8448);
    constexpr int I_IN = (DM / 64) * (INC / 32), I_SQ = (DM / 64) * (DM / 32), I_GU = (DM / 64) * (NGU / 32), I_D = (DFF / 64) * (DM / 32);
    constexpr int NITEMS = I_IN + 3 * I_SQ + I_GU + I_D;
    for (int it = gw; it < NITEMS; it += ngw) {
        int r = it;
        if (r < I_IN) { const int nb = r % (INC / 32), kb = r / (INC / 32); transpose_item(w_in, DM, INC, win_src_col(nb * 32 + (lane & 31)), wb + WO_IN, nb * 32, kb * 64, scr, lane); continue; } r -= I_IN;
        if (r < 3 * I_SQ) { const int which = r / I_SQ; r -= which * I_SQ; const int nb = r % (DM / 32), kb = r / (DM / 32);
            const float* src = which == 0 ? w_attn : (which == 1 ? w_conv : w_out);
            transpose_item(src, DM, DM, nb * 32 + (lane & 31), wb + WO_A + (size_t)which * DM * DM, nb * 32, kb * 64, scr, lane); continue; } r -= 3 * I_SQ;
        if (r < I_GU) { const int nb = r % (NGU / 32), kb = r / (NGU / 32); const int n0 = nb * 32, j = n0 >> 8, c = n0 & 255;
            const float* src = (c < 128) ? w_gate : w_up;
            transpose_item(src, DM, DFF, 128 * j + (c & 127) + (lane & 31), wb + WO_GU, n0, kb * 64, scr, lane); continue; } r -= I_GU;
        { const int nb = r % (DM / 32), kb = r / (DM / 32); transpose_item(w_down, DFF, DM, nb * 32 + (lane & 31), wb + WO_D, nb * 32, kb * 64, scr, lane); }
    }
}

__device__ __forceinline__ void rownorm_phase(const float* X, const float* g, bf16_t* Hout, int gw, int ngw, int lane) {
    f32x4 gv[4];
#pragma unroll
    for (int j = 0; j < 4; ++j) gv[j] = *(const f32x4*)(g + 4 * lane + 256 * j);
    for (int row = gw; row < T; row += ngw) {
        const float* xr = X + (size_t)row * DM + 4 * lane; f32x4 v[4]; float s = 0.f;
#pragma unroll
        for (int j = 0; j < 4; ++j) { v[j] = *(const f32x4*)(xr + 256 * j); s += (v[j][0] * v[j][0] + v[j][1] * v[j][1]) + (v[j][2] * v[j][2] + v[j][3] * v[j][3]); }
        const float rs = 1.0f / sqrtf(wave_sum(s) * (1.0f / DM) + RMS_EPS);
        bf16_t* hr = Hout + (size_t)row * DM + 4 * lane;
#pragma unroll
        for (int j = 0; j < 4; ++j) { const f32x4 o = v[j] * rs * gv[j]; u32x2 w; w.x = cvt_pk_bf16(o[0], o[1]); w.y = cvt_pk_bf16(o[2], o[3]); *(u32x2*)(hr + 256 * j) = w; }
    }
}
template <bool HASH>
__device__ __forceinline__ void rowpass_phase(const float* Y, const float* xbase, float* xout, bf16_t* Hout, const float* gpost, const float* gpre, int gw, int ngw, int lane, bool st_ok) {
    f32x4 gp[4], gq[4];
#pragma unroll
    for (int j = 0; j < 4; ++j) { gp[j] = *(const f32x4*)(gpost + 4 * lane + 256 * j); gq[j] = HASH ? *(const f32x4*)(gpre + 4 * lane + 256 * j) : (f32x4){0.f, 0.f, 0.f, 0.f}; }
    for (int row = gw; row < T; row += ngw) {
        const size_t ro = (size_t)row * DM + 4 * lane;
        f32x4 y[4], x[4]; float s = 0.f;
#pragma unroll
        for (int j = 0; j < 4; ++j) { y[j] = *(const f32x4*)(Y + ro + 256 * j); x[j] = *(const f32x4*)(xbase + ro + 256 * j); s += (y[j][0] * y[j][0] + y[j][1] * y[j][1]) + (y[j][2] * y[j][2] + y[j][3] * y[j][3]); }
        const float rs = 1.0f / sqrtf(wave_sum(s) * (1.0f / DM) + RMS_EPS);
        float s2 = 0.f;
#pragma unroll
        for (int j = 0; j < 4; ++j) { x[j] = x[j] + y[j] * rs * gp[j]; if (st_ok) *(f32x4*)(xout + ro + 256 * j) = x[j]; s2 += (x[j][0] * x[j][0] + x[j][1] * x[j][1]) + (x[j][2] * x[j][2] + x[j][3] * x[j][3]); }
        if (HASH) {
            const float rs2 = 1.0f / sqrtf(wave_sum(s2) * (1.0f / DM) + RMS_EPS);
#pragma unroll
            for (int j = 0; j < 4; ++j) { const f32x4 o = x[j] * rs2 * gq[j]; u32x2 w; w.x = cvt_pk_bf16(o[0], o[1]); w.y = cvt_pk_bf16(o[2], o[3]); if (st_ok) *(u32x2*)(Hout + ro + 256 * j) = w; }
        }
    }
}

__device__ __forceinline__ void sincos_d(double x, double& s, double& c) {
    const double TWO_PI = 6.283185307179586476925286766559, INV_TWO_PI = 0.15915494309189533576888376337251;
    const double k = __builtin_rint(x * INV_TWO_PI); const double r = x - k * TWO_PI; const double r2 = r * r;
    double ts = 1.0, tc = 1.0;
#pragma unroll
    for (int i = 15; i >= 1; --i) { ts = 1.0 - ts * r2 / (double)((2 * i) * (2 * i + 1)); tc = 1.0 - tc * r2 / (double)((2 * i - 1) * (2 * i)); }
    s = ts * r; c = tc;
}
__device__ __forceinline__ void rope_table_phase(float* tab, int gt, int ngt) {
    for (int idx = gt; idx < SEQ * 8; idx += ngt) {
        const int pos = idx >> 3, i = idx & 7;
        float inv;
        switch (i) { case 0: inv = 1.0f; break; case 1: inv = 0.1939227432012558f; break; case 2: inv = 0.03760603070259094f; break; case 3: inv = 0.007292664609849453f; break;
                     case 4: inv = 0.0014142135623842478f; break; case 5: inv = 0.00027424818836152554f; break; case 6: inv = 5.318296098266728e-05f; break; default: inv = 1.0313386155758053e-05f; break; }
        const float ang = (float)pos * inv; double s, c; sincos_d((double)ang, s, c);
        tab[pos * 16 + i] = (float)c; tab[pos * 16 + 8 + i] = (float)s;
    }
}

constexpr int AT_KP = 144, AT_VP = 776, AT_KOFF = 0, AT_VOFF = 384 * AT_KP;
static_assert(AT_VOFF + 64 * AT_VP <= LDS_BYTES, "attention LDS");
template <int NX>
__device__ __forceinline__ void att_tile(LAS const unsigned char* kl, LAS const unsigned char* vl, const bf16x8 (&qr)[4], int jb, bool domask, int lo, unsigned range, int r, int h,
                                         float& m, float& l, f32x16& o0, f32x16& o1) {
    f32x16 p[2];
#pragma unroll
    for (int x = 0; x < NX; ++x) {
        LAS const unsigned char* kp = kl + (jb + 32 * x + r) * AT_KP + h * 16;
        f32x16 a = {};
#pragma unroll
        for (int d0 = 0; d0 < 4; ++d0) { const bf16x8 kf = *(LAS const bf16x8*)(kp + d0 * 32); a = __builtin_amdgcn_mfma_f32_32x32x16_bf16(kf, qr[d0], a, 0, 0, 0); }
        p[x] = a;
    }
    if (domask) {
        const int t = jb + 4 * h - lo;
#pragma unroll
        for (int x = 0; x < NX; ++x)
#pragma unroll
            for (int reg = 0; reg < 16; ++reg) { const int cst = 32 * x + (reg & 3) + 8 * (reg >> 2); if ((unsigned)(t + cst) > range) p[x][reg] = -INFINITY; }
    }
    float mx = p[0][0];
#pragma unroll
    for (int x = 0; x < NX; ++x)
#pragma unroll
        for (int reg = 0; reg < 16; ++reg) mx = fmaxf(mx, p[x][reg]);
    mx = fmaxf(mx, __shfl_xor(mx, 32));
    const float mn = fmaxf(m, mx);
    const float alpha = __builtin_amdgcn_exp2f(m - mn);
    m = mn; l *= alpha;
#pragma unroll
    for (int reg = 0; reg < 16; ++reg) { o0[reg] *= alpha; o1[reg] *= alpha; }
    float ls = 0.f;
#pragma unroll
    for (int x = 0; x < NX; ++x)
#pragma unroll
        for (int reg = 0; reg < 16; ++reg) { p[x][reg] = __builtin_amdgcn_exp2f(p[x][reg] - mn); ls += p[x][reg]; }
    l += ls;
#pragma unroll
    for (int x = 0; x < NX; ++x)
#pragma unroll
        for (int s = 0; s < 2; ++s) {
            u32x4 pw; pw.x = cvt_pk_bf16(p[x][8 * s + 0], p[x][8 * s + 1]); pw.y = cvt_pk_bf16(p[x][8 * s + 2], p[x][8 * s + 3]);
            pw.z = cvt_pk_bf16(p[x][8 * s + 4], p[x][8 * s + 5]); pw.w = cvt_pk_bf16(p[x][8 * s + 6], p[x][8 * s + 7]);
            const bf16x8 pf = __builtin_bit_cast(bf16x8, pw);
            LAS const unsigned char* vp = vl + r * AT_VP + (jb + 32 * x + 16 * s + 4 * h) * 2;
            { const u32x2 a = *(LAS const u32x2*)vp, b = *(LAS const u32x2*)(vp + 16); const u32x4 vw = (u32x4){a.x, a.y, b.x, b.y};
              o0 = __builtin_amdgcn_mfma_f32_32x32x16_bf16(__builtin_bit_cast(bf16x8, vw), pf, o0, 0, 0, 0); }
            { const u32x2 a = *(LAS const u32x2*)(vp + 32 * AT_VP), b = *(LAS const u32x2*)(vp + 32 * AT_VP + 16); const u32x4 vw = (u32x4){a.x, a.y, b.x, b.y};
              o1 = __builtin_amdgcn_mfma_f32_32x32x16_bf16(__builtin_bit_cast(bf16x8, vw), pf, o1, 0, 0, 0); }
        }
}
__device__ __forceinline__ void attn_unit(LAS unsigned char* lds, bf16_t* Q, const bf16_t* Kb, const bf16_t* Vb, const float* sink, int b, int kvh, int qb, int tid, bool st_ok) {
    const int lane = tid & 63, w = __builtin_amdgcn_readfirstlane(tid >> 6), r = lane & 31, h = lane >> 5;
    const int q0 = qb * 128, ks = q0 - 128;
    {
        u32x4 kv[6], vv[6];
#pragma unroll
        for (int i = 0; i < 6; ++i) { const int chunk = tid + 512 * i, j = chunk >> 3, dch = chunk & 7, key = ks + j;
            kv[i] = (u32x4){0u, 0u, 0u, 0u}; vv[i] = (u32x4){0u, 0u, 0u, 0u};
            if (key >= 0 && key < SEQ) { const size_t g = ((size_t)(b * SEQ + key)) * 256 + kvh * 64 + dch * 8; kv[i] = *(const u32x4*)(Kb + g); vv[i] = *(const u32x4*)(Vb + g); } }
#pragma unroll
        for (int i = 0; i < 6; ++i) { const int chunk = tid + 512 * i, j = chunk >> 3, dch = chunk & 7;
            *(LAS u32x4*)(lds + AT_KOFF + j * AT_KP + dch * 16) = kv[i];
            LAS unsigned short* vt = (LAS unsigned short*)(lds + AT_VOFF + (dch * 8) * AT_VP + j * 2);
            vt[0 * (AT_VP / 2)] = (unsigned short)(vv[i].x & 0xffffu); vt[1 * (AT_VP / 2)] = (unsigned short)(vv[i].x >> 16);
            vt[2 * (AT_VP / 2)] = (unsigned short)(vv[i].y & 0xffffu); vt[3 * (AT_VP / 2)] = (unsigned short)(vv[i].y >> 16);
            vt[4 * (AT_VP / 2)] = (unsigned short)(vv[i].z & 0xffffu); vt[5 * (AT_VP / 2)] = (unsigned short)(vv[i].z >> 16);
            vt[6 * (AT_VP / 2)] = (unsigned short)(vv[i].w & 0xffffu); vt[7 * (AT_VP / 2)] = (unsigned short)(vv[i].w >> 16); }
    }
    __syncthreads();
    const int hq = kvh * 4 + (w >> 1);
    const float snk = sink[hq] * LOG2E;
    LAS const unsigned char* kl = lds + AT_KOFF; LAS const unsigned char* vl = lds + AT_VOFF;
    const bool edge = (qb == 0) || (qb == SEQ / 128 - 1);
    for (int rbi = 0; rbi < 2; ++rbi) {
        const int r0 = ((w & 1) * 2 + rbi) * 32;
        bf16_t* qrow = Q + ((size_t)(b * SEQ + q0 + r0 + r)) * 1024 + hq * 64;
        bf16x8 qr[4];
#pragma unroll
        for (int d0 = 0; d0 < 4; ++d0) qr[d0] = *(const bf16x8*)(qrow + 16 * d0 + 8 * h);
        float m = snk, l = (h == 0) ? 1.0f : 0.0f; f32x16 o0 = {}, o1 = {};
        const int jq = r0 + r;
        const int lo = max(jq, 128 - q0), hi = min(jq + 256, SEQ - 1 - q0 + 128);
        const unsigned range = (unsigned)(hi - lo);
        att_tile<2>(kl, vl, qr, r0, true, lo, range, r, h, m, l, o0, o1);
        att_tile<2>(kl, vl, qr, r0 + 64, edge, lo, range, r, h, m, l, o0, o1);
        att_tile<2>(kl, vl, qr, r0 + 128, edge, lo, range, r, h, m, l, o0, o1);
        att_tile<2>(kl, vl, qr, r0 + 192, edge, lo, range, r, h, m, l, o0, o1);
        att_tile<1>(kl, vl, qr, r0 + 256, true, lo, range, r, h, m, l, o0, o1);
        const float lt = l + __shfl_xor(l, 32); const float inv = 1.0f / lt;
#pragma unroll
        for (int g = 0; g < 4; ++g) {
            u32x2 w0, w1;
            w0.x = cvt_pk_bf16(o0[4 * g] * inv, o0[4 * g + 1] * inv); w0.y = cvt_pk_bf16(o0[4 * g + 2] * inv, o0[4 * g + 3] * inv);
            w1.x = cvt_pk_bf16(o1[4 * g] * inv, o1[4 * g + 1] * inv); w1.y = cvt_pk_bf16(o1[4 * g + 2] * inv, o1[4 * g + 3] * inv);
            if (st_ok) { *(u32x2*)(qrow + 8 * g + 4 * h) = w0; *(u32x2*)(qrow + 32 + 8 * g + 4 * h) = w1; }
        }
    }
    __syncthreads();
}
__device__ __forceinline__ void conv_phase(bf16_t* CB, const bf16_t* U, const float* cw, int gw, int ngw, int lane, bool st_ok) {
    for (int run = gw; run < (T / 16) * 2; run += ngw) {
        const int half = run & 1, row0 = (run >> 1) * 16, col = half * 512 + lane * 8, t0 = row0 & (SEQ - 1);
        float w0[8], w1[8], w2[8];
#pragma unroll
        for (int e = 0; e < 8; ++e) { w0[e] = cw[col + e]; w1[e] = cw[1024 + col + e]; w2[e] = cw[2048 + col + e]; }
        u32x4 up = (u32x4){0u, 0u, 0u, 0u}, uc, un;
        if (t0 > 0) up = *(const u32x4*)(U + (size_t)(row0 - 1) * 1024 + col);
        uc = *(const u32x4*)(U + (size_t)row0 * 1024 + col);
#pragma unroll 4
        for (int i = 0; i < 16; ++i) {
            const int row = row0 + i;
            un = (u32x4){0u, 0u, 0u, 0u};
            if (t0 + i + 1 < SEQ) un = *(const u32x4*)(U + (size_t)(row + 1) * 1024 + col);
            const u32x4 cbw = *(const u32x4*)(CB + (size_t)row * 1024 + col);
            u32x4 o;
#pragma unroll
            for (int e = 0; e < 4; ++e) {
                const float a = bf_lo(cbw[e]) * (w0[2 * e] * bf_lo(up[e]) + w1[2 * e] * bf_lo(uc[e]) + w2[2 * e] * bf_lo(un[e]));
                const float b = bf_hi(cbw[e]) * (w0[2 * e + 1] * bf_hi(up[e]) + w1[2 * e + 1] * bf_hi(uc[e]) + w2[2 * e + 1] * bf_hi(un[e]));
                o[e] = cvt_pk_bf16(a, b);
            }
            if (st_ok) *(u32x4*)(CB + (size_t)row * 1024 + col) = o;
            up = uc; uc = un;
        }
    }
}

#define XB_TMO      128
#define XB_XCNT(j)  (256  + 64 * (j))
#define XB_XSUB(j)  (1280 + 64 * (j))
#define XB_XGEN(j)  (2304 + 64 * (j))
#define XB_TOP      3328
#define XB_TOPGEN   3392
#define XCD_BAR_WORDS 3456
#define XB_SPIN_CAP (1u << 18)

__device__ __forceinline__ unsigned xb_ld(unsigned* p)              { return __hip_atomic_load(p, __ATOMIC_RELAXED, __HIP_MEMORY_SCOPE_AGENT); }
__device__ __forceinline__ unsigned xb_add(unsigned* p, unsigned v) { return __hip_atomic_fetch_add(p, v, __ATOMIC_RELAXED, __HIP_MEMORY_SCOPE_AGENT); }
__device__ __forceinline__ unsigned xb_xcc_id() { return (unsigned)__builtin_amdgcn_s_getreg((3 << 11) | 20) & 0xFu; }
#define XB_SPIN(cond, bar) do { unsigned _sp = 0; while (cond) { __builtin_amdgcn_s_sleep(1); \
    if ((++_sp & 255u) == 0u) { if (xb_ld(&(bar)[XB_TMO])) break; if (_sp > XB_SPIN_CAP) { atomicAdd(&(bar)[XB_TMO], 1u); break; } } } } while (0)

struct XcdBarrier {
    unsigned* bar; unsigned x;
    volatile LAS unsigned* st;
};

__device__ __forceinline__ XcdBarrier xcd_barrier_post(unsigned* bar, volatile LAS unsigned* st) {
    XcdBarrier b; b.bar = bar; b.x = xb_xcc_id(); b.st = st;
    if (threadIdx.x == 0) (void)xb_add(&bar[XB_XCNT(b.x)], 1u);
    return b;
}
__device__ __forceinline__ void xcd_barrier_complete(unsigned* bar, unsigned x, unsigned& nloc, unsigned& nx) {
    const unsigned G = gridDim.x * gridDim.y * gridDim.z;
    unsigned sum, cnt, mine, sp = 0u;
    for (;;) {
        sum = 0u; cnt = 0u; mine = 0u;
#pragma unroll
        for (unsigned j = 0; j < 16; ++j) { const unsigned c = xb_ld(&bar[XB_XCNT(j)]); sum += c; cnt += (c > 0u) ? 1u : 0u; mine = (j == x) ? c : mine; }
        if (sum == G) break;
        __builtin_amdgcn_s_sleep(1);
        if ((++sp & 255u) == 0u) { if (xb_ld(&bar[XB_TMO])) break; if (sp > XB_SPIN_CAP) { atomicAdd(&bar[XB_TMO], 1u); break; } }
    }
    nloc = mine > 0u ? mine : 1u; nx = cnt > 0u ? cnt : 1u;
}

__device__ __forceinline__ void xcd_barrier(const XcdBarrier& b) {
    asm volatile("s_waitcnt vmcnt(0)" ::: "memory");
    __syncthreads();
    if (threadIdx.x == 0) {
        unsigned* bar = b.bar;
        __builtin_amdgcn_s_waitcnt(0);
        unsigned nloc = b.st[0], nx = b.st[1];
        if (nloc == 0u) { xcd_barrier_complete(bar, b.x, nloc, nx); b.st[0] = nloc; b.st[1] = nx; }
        const unsigned old = xb_add(&bar[XB_XSUB(b.x)], 1u);
        const unsigned gen = old / nloc;
        if (old + 1u == (gen + 1u) * nloc) {
            __builtin_amdgcn_fence(__ATOMIC_RELEASE, "agent");
            asm volatile("s_waitcnt vmcnt(0)" ::: "memory");
            const unsigned og = xb_add(&bar[XB_TOP], 1u);
            const unsigned tg = og / nx;
            if (og + 1u == (tg + 1u) * nx) xb_add(&bar[XB_TOPGEN], 1u);
            else XB_SPIN(xb_ld(&bar[XB_TOPGEN]) == tg, bar);
            __builtin_amdgcn_fence(__ATOMIC_ACQUIRE, "agent");
            xb_add(&bar[XB_XGEN(b.x)], 1u);
            asm volatile("s_waitcnt vmcnt(0)" ::: "memory");
        } else {
            XB_SPIN(xb_ld(&bar[XB_XGEN(b.x)]) == gen, bar);
            __builtin_amdgcn_fence(__ATOMIC_ACQUIRE, "agent");
            asm volatile("s_waitcnt vmcnt(0)" ::: "memory");
        }
    }
    __syncthreads();
}


#define LAYER_W(l) in2 + (size_t)(l) * DM * INC, in5 + (size_t)(l) * DM * DM, in6 + (size_t)(l) * DM * DM, in7 + (size_t)(l) * DM * DM, in10 + (size_t)(l) * DM * DFF, in11 + (size_t)(l) * DM * DFF, in12 + (size_t)(l) * DFF * DM
__global__ void __launch_bounds__(NTHREADS, 2) fwd(const float* __restrict__ in0, const float* __restrict__ in1, const float* __restrict__ in2, const float* __restrict__ in3, const float* __restrict__ in4,
        const float* __restrict__ in5, const float* __restrict__ in6, const float* __restrict__ in7, const float* __restrict__ in8, const float* __restrict__ in9, const float* __restrict__ in10,
        const float* __restrict__ in11, const float* __restrict__ in12, const float* __restrict__ in13, float* out, unsigned char* wsp, int ph_lo, int ph_hi) {
    extern __shared__ __attribute__((aligned(16))) unsigned char lds_raw[];
    LAS unsigned char* lds = (LAS unsigned char*)lds_raw;
    cg::grid_group grid = cg::this_grid();
    volatile LAS unsigned* misc = (volatile LAS unsigned*)(lds + LDS_MISC);
    if (threadIdx.x < 64) misc[threadIdx.x] = 0u;
    __syncthreads();
    XcdBarrier xbar = xcd_barrier_post((unsigned*)(wsp + WS_BAR), misc);
    for (int ph = ph_lo; ph < ph_hi; ++ph) {
        int tid = threadIdx.x; asm volatile("" : "+v"(tid));
        const int lane = tid & 63, wave = __builtin_amdgcn_readfirstlane(tid >> 6);
        int G = gridDim.x, bx = blockIdx.x; asm volatile("" : "+s"(G), "+s"(bx));
        const int gw = bx * NWAVES + wave, ngw = G * NWAVES;
        size_t zoff = 0; asm volatile("" : "+s"(zoff));
        unsigned char* ws = wsp + zoff;
        float* rope = (float*)(ws + WS_ROPE);
        bf16_t* Hb = (bf16_t*)(ws + WS_H);
        unsigned char* Z = ws + WS_Z;
        bf16_t *Qb = (bf16_t*)(Z + ZQ), *Kb = (bf16_t*)(Z + ZK), *Vb = (bf16_t*)(Z + ZV), *CBb = (bf16_t*)(Z + ZCB), *Ub = (bf16_t*)(Z + ZU), *SGAb = (bf16_t*)(Z + ZSGA), *SGBb = (bf16_t*)(Z + ZSGB);
        float* Yb = (float*)(Z + ZY); bf16_t* ACTb = (bf16_t*)(Z + ZACT);
        float* xout = out + zoff;
        if (ph == 0) {
            convert_layer(LAYER_W(0), (bf16_t*)(ws + WS_W0), lds, gw, ngw, wave, lane);
            rope_table_phase(rope, bx * NTHREADS + tid, G * NTHREADS);
            rownorm_phase(in0 + zoff, in1, Hb, gw, ngw, lane);
        } else {
            const int l = (ph - 1) / PROBE_N; const int code = (int)((PROBE_TAB >> (4 * ((ph - 1) % PROBE_N))) & 0xFull); const int s = code & 7;
            const bool st_ok = ((code & 8) == 0) || (ph_hi < 0);
            const bf16_t* wb = (const bf16_t*)(ws + WS_W0 + (size_t)(l & 1) * WS_WSTRIDE);
            if (s == 0) {
                pg8::SchedG S; S.o.init(T, INC, G, bx); S.A = (const char*)Hb; S.Bt = (const char*)(wb + WO_IN); S.ta = (size_t)256 * DM * 2; S.tb = (size_t)256 * DM * 2;
                EpiIn E{Qb, Kb, Vb, CBb, Ub, SGAb, SGBb, rope};
                pg8::gemm_phase<EpiIn, pg8::SchedG, true, true>(lds, tid, DM, S, E);
            } else if (s == 1) {
                const float* sink = in3 + l * NH;
                if (st_ok || (PROBE_PART & 1)) for (int unit = bx; unit < BATCH * NKV * (SEQ / 128); unit += G) {
                    const int qb = unit & 31, kvh = (unit >> 5) & 3, b = unit >> 7;
                    attn_unit(lds, Qb, Kb, Vb, sink, b, kvh, qb, tid, st_ok);
                }
                if (st_ok || (PROBE_PART & 2)) conv_phase(CBb, Ub, in4 + (size_t)l * 3 * DM, gw, ngw, lane, st_ok);
            } else if (s == 2) {
                pg8::SchedPair S; S.o.init(T, DM, G, bx); S.A0 = (const char*)Qb; S.A1 = (const char*)CBb; S.B0 = (const char*)(wb + WO_A); S.B1 = (const char*)(wb + WO_C);
                S.ta = (size_t)256 * DM * 2; S.tb = (size_t)256 * DM * 2;
                EpiMix E{SGAb, SGBb, Hb};
                pg8::gemm_phase<EpiMix, pg8::SchedPair, true, true>(lds, tid, DM, S, E);
            } else if (s == 3 || s == 6) {
                pg8::SchedG S; S.o.init(T, DM, G, bx);
                const int K = (s == 3) ? DM : DFF;
                S.A = (s == 3) ? (const char*)Hb : (const char*)ACTb; S.Bt = (const char*)(wb + ((s == 3) ? WO_O : WO_D)); S.ta = (size_t)256 * K * 2; S.tb = (size_t)256 * K * 2;
                EpiF32 E{Yb};
                pg8::gemm_phase<EpiF32, pg8::SchedG, true, true>(lds, tid, K, S, E);
            } else if (s == 4) {
                rowpass_phase<true>(Yb, (l == 0) ? in0 : (const float*)xout, xout, Hb, in8 + l * DM, in9 + l * DM, gw, ngw, lane, st_ok);
                if (st_ok && l + 1 < DEPTH) convert_layer(LAYER_W(l + 1), (bf16_t*)(ws + WS_W0 + (size_t)((l + 1) & 1) * WS_WSTRIDE), lds, gw, ngw, wave, lane);
            } else if (s == 5) {
                pg8::SchedG S; S.o.init(T, NGU, G, bx); S.A = (const char*)Hb; S.Bt = (const char*)(wb + WO_GU); S.ta = (size_t)256 * DM * 2; S.tb = (size_t)256 * DM * 2;
                EpiAct E{ACTb};
                pg8::gemm_phase<EpiAct, pg8::SchedG, true, true>(lds, tid, DM, S, E);
            } else {
                if (l + 1 < DEPTH) rowpass_phase<true>(Yb, xout, xout, Hb, in13 + l * DM, in1 + (l + 1) * DM, gw, ngw, lane, st_ok);
                else rowpass_phase<false>(Yb, xout, xout, Hb, in13 + l * DM, in1, gw, ngw, lane, st_ok);
            }
        }
        if (ph + 1 < ph_hi) { if (ph == ph_lo) grid.sync(); else xcd_barrier(xbar); if (PROBE_SYNC2) xcd_barrier(xbar); }
    }
}

extern "C" void kernel_launch(void* const* d_in, const int* in_sizes, int n_in, void* d_out, int out_size, void* d_ws, size_t ws_size, hipStream_t stream) {
    static int grid = 0;
    if (grid == 0) {
        if (n_in != 14 || in_sizes[0] != T * DM || out_size != T * DM || ws_size < WS_END) { fprintf(stderr, "kernel_launch: unexpected shapes / workspace (%d inputs, ws %zu)\n", n_in, ws_size); grid = -1; return; }
        int dev = 0, cus = 0, per_cu = 0;
        if (hipGetDevice(&dev) != hipSuccess || hipDeviceGetAttribute(&cus, hipDeviceAttributeMultiprocessorCount, dev) != hipSuccess) { grid = -1; return; }
        if (hipFuncSetAttribute((const void*)fwd, hipFuncAttributeMaxDynamicSharedMemorySize, LDS_BYTES) != hipSuccess) { fprintf(stderr, "kernel_launch: hipFuncSetAttribute failed\n"); grid = -1; return; }
        if (hipOccupancyMaxActiveBlocksPerMultiprocessor(&per_cu, (const void*)fwd, NTHREADS, LDS_BYTES) != hipSuccess || per_cu < 1) { fprintf(stderr, "kernel_launch: occupancy query failed (%d)\n", per_cu); (void)hipGetLastError(); per_cu = 1; }
        grid = cus * per_cu;
    }
    if (grid < 0) return;
    if (hipMemsetAsync((char*)d_ws + WS_BAR, 0, WS_BAR_BYTES, stream) != hipSuccess) { fprintf(stderr, "kernel_launch: memset failed\n"); return; }
    const float* in[14];
    for (int i = 0; i < 14; ++i) in[i] = (const float*)d_in[i];
    float* outp = (float*)d_out; unsigned char* wsp = (unsigned char*)d_ws;
#if MK_MULTI
    for (int ph = 0; ph < NPHASES; ++ph)
        hipLaunchKernelGGL(fwd, dim3(grid), dim3(NTHREADS), LDS_BYTES, stream, in[0], in[1], in[2], in[3], in[4], in[5], in[6], in[7], in[8], in[9], in[10], in[11], in[12], in[13], outp, wsp, ph, ph + 1);
#else
    int ph_lo = 0, ph_hi = NPHASES;
    void* args[] = {&in[0], &in[1], &in[2], &in[3], &in[4], &in[5], &in[6], &in[7], &in[8], &in[9], &in[10], &in[11], &in[12], &in[13], &outp, &wsp, &ph_lo, &ph_hi};
    hipError_t e = hipLaunchCooperativeKernel((const void*)fwd, dim3(grid), dim3(NTHREADS), args, LDS_BYTES, stream);
    if (e != hipSuccess) fprintf(stderr, "kernel_launch: cooperative launch failed: %s (grid %d)\n", hipGetErrorString(e), grid);
#endif
}
```
